# Optimizing an MI355X kernel written in HIP

```python
import math
import jax, jax.numpy as jnp
from jax import lax
import numpy as np

D_MODEL = 1024
BATCH = 8
SEQ = 2048
DEPTH = 4
DEC_BATCH = 128
DEC_SEQ = 1
PAST_LEN = 16384
PAGE_SIZE = 128

N_MIXERS = 3
N_POOL_LAYERS = (DEPTH + 2) // 3
N_GDN_LAYERS = (DEPTH + 1) // 3
N_RET_LAYERS = DEPTH // 3

POOL_WINDOWS = (2, 4, 8, 16)
N_POOL_GROUPS = len(POOL_WINDOWS)
POOL_GROUP = D_MODEL // N_POOL_GROUPS
POOL_BUF = max(POOL_WINDOWS) - 1

GDN_HEADS = 8
GDN_DK = D_MODEL // GDN_HEADS
GDN_DV = D_MODEL // GDN_HEADS
GDN_CONV = 4
GDN_CONV_CH = GDN_HEADS * (2 * GDN_DK + GDN_DV)
GDN_IN = GDN_CONV_CH + GDN_HEADS * GDN_DV + 2 * GDN_HEADS

RET_HEADS = 8
RET_DK = D_MODEL // RET_HEADS
RET_DV = 2 * RET_DK
RET_IN = 2 * RET_HEADS * RET_DK + 2 * RET_HEADS * RET_DV
ROPE_BASE = 10000.0

D_FF = -(-8 * D_MODEL // (3 * 256)) * 256
CHUNK = 64
DN_ALPHA = (2 * DEPTH) ** 0.25
DN_BETA = (8 * DEPTH) ** -0.25
LN_EPS = 1e-5
RMS_EPS = 1e-6

kernel_name = 'hybrid_pool_gdn_retention_decode_step'

F32 = jnp.float32


def chunk_len(T):
    return CHUNK if T % CHUNK == 0 else T


def layer_norm(x, g, b):
    x32 = x.astype(F32)
    mu = jnp.mean(x32, -1, keepdims=True)
    var = jnp.mean(jnp.square(x32 - mu), -1, keepdims=True)
    return ((x32 - mu) * lax.rsqrt(var + LN_EPS) * g.astype(F32) + b.astype(F32)).astype(x.dtype)


def swiglu(x, w13, w2):
    a, b = jnp.split(x @ w13, 2, axis=-1)
    return (jax.nn.silu(a) * b) @ w2


def l2norm(x):
    return x * lax.rsqrt(jnp.sum(x * x, -1, keepdims=True) + RMS_EPS)


def rope(x, pos):
    half = x.shape[-1] // 2
    freqs = ROPE_BASE ** (-jnp.arange(half, dtype=F32) / half)
    ang = pos[:, None] * freqs[None, :]
    cos = jnp.cos(ang)[None, :, None, :]
    sin = jnp.sin(ang)[None, :, None, :]
    x1, x2 = x[..., :half], x[..., half:]
    return jnp.concatenate([x1 * cos - x2 * sin, x1 * sin + x2 * cos], axis=-1)


def pool_mixer(x, buf, n_valid, w, scale):
    T = x.shape[1]
    P = POOL_BUF
    ext = jnp.concatenate([buf.astype(x.dtype), x], axis=1)
    c = jnp.pad(jnp.cumsum(ext.astype(F32), axis=1), ((0, 0), (1, 0), (0, 0)))
    t = jnp.arange(T)
    means = []
    for gi, win in enumerate(POOL_WINDOWS):
        lo, hi = gi * POOL_GROUP, (gi + 1) * POOL_GROUP
        s = c[:, P + 1:P + 1 + T, lo:hi] - c[:, P + 1 - win:P + 1 - win + T, lo:hi]
        cnt = jnp.minimum(t + 1 + n_valid, win).astype(F32)
        means.append(s / cnt[None, :, None])
    pooled = jnp.concatenate(means, axis=-1) - x.astype(F32)
    B = x.shape[0]
    pg = pooled.reshape(B, T, N_POOL_GROUPS, POOL_GROUP)
    out = jnp.einsum('btgc,gcd->btgd', pg, w.astype(F32)).reshape(B, T, D_MODEL)
    return (out * scale.astype(F32)).astype(x.dtype), ext[:, -P:]


def causal_conv(u, buf, w):
    T = u.shape[1]
    ext = jnp.concatenate([buf.astype(u.dtype), u], axis=1)
    y = ext[:, 0:T] * w[0]
    for j in range(1, GDN_CONV):
        y = y + ext[:, j:j + T] * w[j]
    return jax.nn.silu(y), ext[:, -(GDN_CONV - 1):]


def gated_delta_rule(q, k, v, g, beta, S0):
    B, T, H, dk = q.shape
    dv = v.shape[-1]
    C = chunk_len(T)
    N = T // C

    def blocks(a):
        a = jnp.moveaxis(a, 2, 1)
        return a.reshape((B, H, N, C) + a.shape[3:])

    q, k, v, g, beta = blocks(q), blocks(k), blocks(v), blocks(g), blocks(beta)
    gc = jnp.cumsum(g, axis=-1)
    lower = jnp.tril(jnp.ones((C, C), bool))
    strict = jnp.tril(jnp.ones((C, C), bool), -1)
    diff = gc[..., :, None] - gc[..., None, :]
    decay = jnp.where(lower, jnp.exp(jnp.where(lower, diff, 0.0)), 0.0)
    kb = k * beta[..., None]
    Lm = jnp.where(strict, jnp.einsum('bhnid,bhnjd->bhnij', kb, k) * decay, 0.0)
    eye = jnp.eye(C, dtype=F32)
    Tinv = lax.linalg.triangular_solve(eye + Lm, jnp.broadcast_to(eye, Lm.shape),
                                       left_side=True, lower=True, unit_diagonal=True)
    u = jnp.einsum('bhnij,bhnje->bhnie', Tinv, v * beta[..., None])
    wk = jnp.einsum('bhnij,bhnjd->bhnid', Tinv, kb * jnp.exp(gc)[..., None])
    attn = jnp.einsum('bhnid,bhnjd->bhnij', q, k) * decay
    qg = q * jnp.exp(gc)[..., None]
    kg = k * jnp.exp(gc[..., -1:] - gc)[..., None]
    glast = jnp.exp(gc[..., -1])
    xs = tuple(jnp.moveaxis(a, 2, 0) for a in (u, wk, attn, qg, kg, glast))

    def step(S, xn):
        u_n, w_n, a_n, qg_n, kg_n, gl_n = xn
        v_new = u_n - jnp.einsum('bhcd,bhde->bhce', w_n, S)
        o_n = jnp.einsum('bhcd,bhde->bhce', qg_n, S) + jnp.einsum('bhij,bhje->bhie', a_n, v_new)
        S = S * gl_n[..., None, None] + jnp.einsum('bhcd,bhce->bhde', kg_n, v_new)
        return S, o_n

    S, o = lax.scan(step, S0, xs)
    o = jnp.moveaxis(o, 0, 2).reshape(B, H, T, dv)
    return jnp.moveaxis(o, 1, 2), S


def gdn_mixer(x, conv_buf, S0, w_in, conv_w, a_log, dt_bias, norm_g, w_out):
    B, T, _ = x.shape
    H, dk, dv = GDN_HEADS, GDN_DK, GDN_DV
    proj = x @ w_in
    qkv, new_buf = causal_conv(proj[..., :GDN_CONV_CH], conv_buf, conv_w)
    o1 = GDN_CONV_CH + H * dv
    z = proj[..., GDN_CONV_CH:o1].astype(F32)
    b_logit = proj[..., o1:o1 + H].astype(F32)
    a_in = proj[..., o1 + H:].astype(F32)
    qkv = qkv.astype(F32)
    q = l2norm(qkv[..., :H * dk].reshape(B, T, H, dk)) * dk ** -0.5
    k = l2norm(qkv[..., H * dk:2 * H * dk].reshape(B, T, H, dk))
    v = qkv[..., 2 * H * dk:].reshape(B, T, H, dv)
    beta = jax.nn.sigmoid(b_logit)
    g = -jnp.exp(a_log.astype(F32)) * jax.nn.softplus(a_in + dt_bias.astype(F32))
    o, S = gated_delta_rule(q, k, v, g, beta, S0.astype(F32))
    o = o * lax.rsqrt(jnp.mean(o * o, -1, keepdims=True) + RMS_EPS) * norm_g.astype(F32)
    o = (o.reshape(B, T, H * dv) * jax.nn.silu(z)).astype(x.dtype)
    return o @ w_out, new_buf, S.astype(S0.dtype)


def retention(q, k, v, S0):
    B, T, H, dk = q.shape
    dv = v.shape[-1]
    C = chunk_len(T)
    N = T // C
    lg = jnp.log(1.0 - 2.0 ** (-5.0 - jnp.arange(H, dtype=F32)))
    idx = jnp.arange(C, dtype=F32)
    diff = idx[:, None] - idx[None, :]
    decay = jnp.where(diff >= 0, jnp.exp(jnp.maximum(diff, 0.0)[None] * lg[:, None, None]), 0.0)
    xi = jnp.exp((idx + 1.0)[None, :] * lg[:, None])
    zeta = jnp.exp((C - 1.0 - idx)[None, :] * lg[:, None])
    gC = jnp.exp(C * lg)

    def blocks(a):
        a = jnp.moveaxis(a, 2, 1)
        return a.reshape((B, H, N, C) + a.shape[3:])

    q, k, v = blocks(q), blocks(k), blocks(v)
    attn = jnp.einsum('bhnid,bhnjd->bhnij', q, k) * decay[:, None]
    inner = jnp.einsum('bhnij,bhnje->bhnie', attn, v)
    qx = q * xi[:, None, :, None]
    kz = k * zeta[:, None, :, None]
    xs = tuple(jnp.moveaxis(a, 2, 0) for a in (inner, qx, kz, v))

    def step(S, xn):
        in_n, qx_n, kz_n, v_n = xn
        o_n = in_n + jnp.einsum('bhcd,bhde->bhce', qx_n, S)
        S = gC[:, None, None] * S + jnp.einsum('bhcd,bhce->bhde', kz_n, v_n)
        return S, o_n

    S, o = lax.scan(step, S0, xs)
    o = jnp.moveaxis(o, 0, 2).reshape(B, H, T, dv)
    return jnp.moveaxis(o, 1, 2), S


def retention_mixer(x, S0, pos0, w_in, w_out):
    B, T, _ = x.shape
    H, dk, dv = RET_HEADS, RET_DK, RET_DV
    proj = (x @ w_in).astype(F32)
    q = proj[..., :H * dk].reshape(B, T, H, dk)
    k = proj[..., H * dk:2 * H * dk].reshape(B, T, H, dk)
    v = proj[..., 2 * H * dk:2 * H * dk + H * dv].reshape(B, T, H, dv)
    gate = proj[..., 2 * H * dk + H * dv:]
    pos = pos0 + jnp.arange(T, dtype=F32)
    q = rope(q, pos)
    k = rope(k, pos) * dk ** -0.5
    o, S = retention(q, k, v, S0.astype(F32))
    mu = jnp.mean(o, -1, keepdims=True)
    var = jnp.mean(jnp.square(o - mu), -1, keepdims=True)
    o = (o - mu) * lax.rsqrt(var + LN_EPS)
    o = (jax.nn.silu(gate) * o.reshape(B, T, H * dv)).astype(x.dtype)
    return o @ w_out, S.astype(S0.dtype)


def trunk(x, pool_buf, pool_valid, conv_buf, gdn_S, ret_S, pos0,
          pool_w, pool_scale, gdn_w_in, gdn_conv_w, gdn_a_log, gdn_dt_bias, gdn_norm_g, gdn_w_out,
          ret_w_in, ret_w_out, ffn_w13, ffn_w2, ln_g, ln_b):
    new_pool, new_conv, new_gdn, new_ret = [], [], [], []
    for i in range(DEPTH):
        kind, j = i % N_MIXERS, i // N_MIXERS
        if kind == 0:
            mix, nb = pool_mixer(x, pool_buf[j], pool_valid, pool_w[j], pool_scale[j])
            new_pool.append(nb)
        elif kind == 1:
            mix, nc, ns = gdn_mixer(x, conv_buf[j], gdn_S[j], gdn_w_in[j], gdn_conv_w[j], gdn_a_log[j],
                                    gdn_dt_bias[j], gdn_norm_g[j], gdn_w_out[j])
            new_conv.append(nc)
            new_gdn.append(ns)
        else:
            mix, ns = retention_mixer(x, ret_S[j], pos0, ret_w_in[j], ret_w_out[j])
            new_ret.append(ns)
        x = layer_norm(DN_ALPHA * x + mix, ln_g[i, 0], ln_b[i, 0])
        x = layer_norm(DN_ALPHA * x + swiglu(x, ffn_w13[i], ffn_w2[i]), ln_g[i, 1], ln_b[i, 1])
    return x, jnp.stack(new_pool), jnp.stack(new_conv), jnp.stack(new_gdn), jnp.stack(new_ret)


def setup_inputs(seed: int = 0) -> dict:
    key = jax.random.key(seed)
    ks = jax.random.split(key, 20)

    def nrm(k, shape, s):
        return jax.random.normal(k, shape, F32) * s

    x_prompt = nrm(ks[0], (BATCH, SEQ, D_MODEL), 1.0)
    x_sample = nrm(ks[1], (DEC_BATCH, DEC_SEQ, D_MODEL), 1.0)
    state_pool = nrm(ks[2], (N_POOL_LAYERS, DEC_BATCH, POOL_BUF, D_MODEL), 1.0)
    state_gdn_conv = nrm(ks[3], (N_GDN_LAYERS, DEC_BATCH, GDN_CONV - 1, GDN_CONV_CH), 1.0)
    state_gdn = nrm(ks[4], (N_GDN_LAYERS, DEC_BATCH, GDN_HEADS, GDN_DK, GDN_DV), GDN_DK ** -0.5)
    state_ret = nrm(ks[5], (N_RET_LAYERS, DEC_BATCH, RET_HEADS, RET_DK, RET_DV), 0.1)
    pool_w = nrm(ks[6], (N_POOL_LAYERS, N_POOL_GROUPS, POOL_GROUP, POOL_GROUP), POOL_GROUP ** -0.5 * DN_BETA)
    pool_scale = 1.0 + nrm(ks[7], (N_POOL_LAYERS, D_MODEL), 0.05)
    gdn_w_in = nrm(ks[8], (N_GDN_LAYERS, D_MODEL, GDN_IN), D_MODEL ** -0.5)
    gdn_conv_w = nrm(ks[9], (N_GDN_LAYERS, GDN_CONV, GDN_CONV_CH), GDN_CONV ** -0.5)
    gdn_a_log = jnp.log(jax.random.uniform(ks[10], (N_GDN_LAYERS, GDN_HEADS), F32, 1.0, 16.0))
    dt = jnp.exp(jax.random.uniform(ks[11], (N_GDN_LAYERS, GDN_HEADS), F32, math.log(1e-3), math.log(1e-1)))
    gdn_dt_bias = dt + jnp.log(-jnp.expm1(-dt))
    gdn_norm_g = 1.0 + nrm(ks[12], (N_GDN_LAYERS, GDN_DV), 0.05)
    gdn_w_out = nrm(ks[13], (N_GDN_LAYERS, GDN_HEADS * GDN_DV, D_MODEL), (GDN_HEADS * GDN_DV) ** -0.5 * DN_BETA)
    ret_w_in = nrm(ks[14], (N_RET_LAYERS, D_MODEL, RET_IN), D_MODEL ** -0.5)
    ret_w_out = nrm(ks[15], (N_RET_LAYERS, RET_HEADS * RET_DV, D_MODEL), (RET_HEADS * RET_DV) ** -0.5 * DN_BETA)
    ffn_w13 = nrm(ks[16], (DEPTH, D_MODEL, 2 * D_FF), D_MODEL ** -0.5)
    ffn_w2 = nrm(ks[17], (DEPTH, D_FF, D_MODEL), D_FF ** -0.5 * DN_BETA)
    ln_g = 1.0 + nrm(ks[18], (DEPTH, 2, D_MODEL), 0.05)
    ln_b = nrm(ks[19], (DEPTH, 2, D_MODEL), 0.02)
    return {'x_prompt': x_prompt, 'x_sample': x_sample,
            'state_pool': state_pool, 'state_gdn_conv': state_gdn_conv,
            'state_gdn': state_gdn, 'state_ret': state_ret,
            'pool_w': pool_w, 'pool_scale': pool_scale,
            'gdn_w_in': gdn_w_in, 'gdn_conv_w': gdn_conv_w, 'gdn_a_log': gdn_a_log,
            'gdn_dt_bias': gdn_dt_bias, 'gdn_norm_g': gdn_norm_g, 'gdn_w_out': gdn_w_out,
            'ret_w_in': ret_w_in, 'ret_w_out': ret_w_out,
            'ffn_w13': ffn_w13, 'ffn_w2': ffn_w2, 'ln_g': ln_g, 'ln_b': ln_b}


def reference(x_prompt, x_sample, state_pool, state_gdn_conv, state_gdn, state_ret,
              pool_w, pool_scale, gdn_w_in, gdn_conv_w, gdn_a_log, gdn_dt_bias, gdn_norm_g, gdn_w_out,
              ret_w_in, ret_w_out, ffn_w13, ffn_w2, ln_g, ln_b):
    pool0 = jnp.zeros((N_POOL_LAYERS, BATCH, POOL_BUF, D_MODEL), x_prompt.dtype)
    conv0 = jnp.zeros((N_GDN_LAYERS, BATCH, GDN_CONV - 1, GDN_CONV_CH), x_prompt.dtype)
    gdn0 = jnp.zeros((N_GDN_LAYERS, BATCH, GDN_HEADS, GDN_DK, GDN_DV), state_gdn.dtype)
    ret0 = jnp.zeros((N_RET_LAYERS, BATCH, RET_HEADS, RET_DK, RET_DV), state_ret.dtype)
    y_prompt, pool_p, conv_p, gdn_p, ret_p = trunk(
        x_prompt, pool0, 0, conv0, gdn0, ret0, 0,
        pool_w, pool_scale, gdn_w_in, gdn_conv_w, gdn_a_log, gdn_dt_bias, gdn_norm_g, gdn_w_out,
        ret_w_in, ret_w_out, ffn_w13, ffn_w2, ln_g, ln_b)
    y_sample, pool_s, conv_s, gdn_s, ret_s = trunk(
        x_sample, state_pool, min(PAST_LEN, POOL_BUF), state_gdn_conv, state_gdn, state_ret, PAST_LEN,
        pool_w, pool_scale, gdn_w_in, gdn_conv_w, gdn_a_log, gdn_dt_bias, gdn_norm_g, gdn_w_out,
        ret_w_in, ret_w_out, ffn_w13, ffn_w2, ln_g, ln_b)
    return (y_prompt, y_sample, pool_p, pool_s, conv_p, conv_s, gdn_p, gdn_s, ret_p, ret_s)
```

```cpp
#include <hip/hip_runtime.h>
#include <hip/hip_cooperative_groups.h>
#include <cstdio>
namespace cg = cooperative_groups;

#ifndef N_LAUNCHES
#define N_LAUNCHES 1
#endif

#ifndef PH_MASK
#define PH_MASK 0x7ffff
#endif
#define EN(x) (((PH_MASK) >> (x)) & 1)
#define LAS __attribute__((address_space(3)))
typedef unsigned short bf16_t;
typedef short bf16x8 __attribute__((ext_vector_type(8)));
typedef float f32x4 __attribute__((ext_vector_type(4)));
typedef float f32x2 __attribute__((ext_vector_type(2)));
typedef unsigned u32x4 __attribute__((ext_vector_type(4)));
typedef unsigned u32x2 __attribute__((ext_vector_type(2)));

constexpr int D = 1024, NB = 8, T = 2048, MPR = NB * T, NS = 128, MR = MPR + NS, MP = 16640;
constexpr int DFF = 2816, GIN = 4112, GINP = 4352, RIN = 6144, PBUF = 15, CCH = 3072;
constexpr float DN_ALPHA = 1.6817928305074290f;
constexpr float LN_EPS = 1e-5f, RMS_EPS = 1e-6f;
constexpr int NPH = 19;
constexpr int LDS_BYTES = 147456;

constexpr size_t O_YP = 0;
constexpr size_t O_YS = O_YP + (size_t)MPR * D;
constexpr size_t O_PP = O_YS + (size_t)NS * D;
constexpr size_t O_PS = O_PP + (size_t)2 * NB * PBUF * D;
constexpr size_t O_CP = O_PS + (size_t)2 * NS * PBUF * D;
constexpr size_t O_CS = O_CP + (size_t)NB * 3 * CCH;
constexpr size_t O_GP = O_CS + (size_t)NS * 3 * CCH;
constexpr size_t O_GS = O_GP + (size_t)NB * 8 * 128 * 128;
constexpr size_t O_RP = O_GS + (size_t)NS * 8 * 128 * 128;
constexpr size_t O_RS = O_RP + (size_t)NB * 8 * 128 * 256;
constexpr size_t O_END = O_RS + (size_t)NS * 8 * 128 * 256;

constexpr size_t al256(size_t x) { return (x + 255) & ~(size_t)255; }
constexpr size_t WS_STATS = 0;
constexpr size_t NCFOLD = 4 * 5632 + GINP + RIN;
constexpr size_t WS_C1 = al256(WS_STATS + (size_t)8 * MP * 32 * 4);
constexpr size_t WS_C2 = al256(WS_C1 + NCFOLD * 4);
constexpr size_t WS_ZERO_END = al256(WS_C2 + NCFOLD * 4);
constexpr size_t WS_WPOOL = WS_ZERO_END;
constexpr size_t WS_W13 = al256(WS_WPOOL + (size_t)2 * 4 * 256 * 256 * 2);
constexpr size_t WS_W2 = al256(WS_W13 + (size_t)4 * 5632 * 1024 * 2);
constexpr size_t WS_WGI = al256(WS_W2 + (size_t)4 * 1024 * 2816 * 2);
constexpr size_t WS_WGO = al256(WS_WGI + (size_t)GINP * 1024 * 2);
constexpr size_t WS_WRI = al256(WS_WGO + (size_t)1024 * 1024 * 2);
constexpr size_t WS_WRO = al256(WS_WRI + (size_t)RIN * 1024 * 2);
constexpr size_t WS_ROPE = al256(WS_WRO + (size_t)1024 * 2048 * 2);
constexpr size_t WS_YA = al256(WS_ROPE + (size_t)2049 * 64 * 2 * 4);
constexpr size_t WS_YB = al256(WS_YA + (size_t)MP * D * 2);
constexpr size_t WS_O = al256(WS_YB + (size_t)MP * D * 2);
constexpr size_t WS_PROJS = al256(WS_O + (size_t)MP * 2048 * 2);
constexpr size_t WS_BIG = al256(WS_PROJS + (size_t)MP * 16 * 4);
constexpr size_t WS_END = al256(WS_BIG + (size_t)MP * RIN * 2);

struct Params { const float* in[20]; float* out; unsigned char* ws; int ph_lo, ph_hi; };
constexpr int PTAB_OFF = 144 * 1024 - 256;
struct Ctx {
    const unsigned __attribute__((address_space(3)))* tab;
    __device__ __forceinline__ unsigned long long raw(int i) const {
        const unsigned lo = __builtin_amdgcn_readfirstlane(tab[2 * i]), hi = __builtin_amdgcn_readfirstlane(tab[2 * i + 1]);
        return ((unsigned long long)hi << 32) | lo; }
    __device__ __forceinline__ const float* in(int i) const { return (const float*)raw(i); }
    __device__ __forceinline__ float* out() const { return (float*)raw(20); }
    __device__ __forceinline__ unsigned char* ws() const { return (unsigned char*)raw(21); }
};

__device__ __forceinline__ unsigned cvt_pk_bf16(float lo, float hi) { unsigned r; asm("v_cvt_pk_bf16_f32 %0, %1, %2" : "=v"(r) : "v"(lo), "v"(hi)); return r; }
__device__ __forceinline__ float bf_lo(unsigned w) { return __uint_as_float(w << 16); }
__device__ __forceinline__ float bf_hi(unsigned w) { return __uint_as_float(w & 0xffff0000u); }
__device__ __forceinline__ float bf2f(bf16_t b) { return __uint_as_float(((unsigned)b) << 16); }
__device__ __forceinline__ bf16_t f2bf(float f) { return (bf16_t)(cvt_pk_bf16(f, 0.f) & 0xffffu); }
__device__ __forceinline__ float fsigmoid(float x) { return __builtin_amdgcn_rcpf(1.0f + __expf(-x)); }
__device__ __forceinline__ float fsilu(float x) { return x * fsigmoid(x); }
__device__ __forceinline__ int opaque_tid() { int t = threadIdx.x; asm volatile("" : "+v"(t)); return t; }
__device__ __forceinline__ float wave_sum(float v) {
#pragma unroll
    for (int o = 32; o >= 1; o >>= 1) v += __shfl_xor(v, o);
    return v;
}
__device__ __forceinline__ void ln_finish(float s, float q, float& mu, float& rstd) {
    mu = s * (1.0f / 1024.0f);
    const float var = fmaxf(q * (1.0f / 1024.0f) - mu * mu, 0.f);
    rstd = rsqrtf(var + LN_EPS);
}
__device__ __forceinline__ void ln_stats(const float* st, int r, float& mu, float& rstd) {
    const f32x4* sp = (const f32x4*)(st + 32 * (size_t)r);
    float s = 0.f, q = 0.f;
#pragma unroll
    for (int i = 0; i < 8; ++i) { const f32x4 v = sp[i]; s += v.x; q += v.y; s += v.z; q += v.w; }
    ln_finish(s, q, mu, rstd);
}
__device__ __forceinline__ void ln_stats4(const float* st, int r, int fq, float& mu, float& rstd) {
    const f32x4* sp = (const f32x4*)(st + 32 * (size_t)r) + 2 * fq;
    const f32x4 v0 = sp[0], v1 = sp[1];
    float s = (v0.x + v0.z) + (v1.x + v1.z), q = (v0.y + v0.w) + (v1.y + v1.w);
    s += __shfl_xor(s, 16); q += __shfl_xor(q, 16); s += __shfl_xor(s, 32); q += __shfl_xor(q, 32);
    ln_finish(s, q, mu, rstd);
}

namespace pg8 {
constexpr int BM = 256, BK = 64, HALF = 128, HTB = HALF * BK * 2, STAGE_BYTES = 8 * HTB, NXCD = 8, WGM = 8;
__device__ __forceinline__ int lds_byte(int r, int c) { const int st = (r >> 4) * 2 + (c >> 5), rr = r & 15, cc = c & 31, ob = rr * 64 + cc * 2; return st * 1024 + (ob ^ (((ob >> 9) & 1) << 5)); }
__device__ __forceinline__ void stage_rc(int b, int& R, int& C) { const int st = b / 1024, sb = b % 1024, swz = sb ^ (((sb >> 9) & 1) << 5); R = (st >> 1) * 16 + swz / 64; C = (st & 1) * 32 + (swz % 64) / 2; }
__device__ __forceinline__ int perm32(int rho) { const int n = rho >> 4, i = rho & 15; return 8 * (i >> 2) + 4 * n + (i & 3); }

struct Unit { int pm, pn; };
struct Gemm { const bf16_t* A; const bf16_t* Bt; int lda, K, nM, nN, apn; };

struct StaticOrder {
    int nM, nN, nwg, G, c;
    __device__ void init(int nM_, int nN_, int G_, int c_) { nM = nM_; nN = nN_; nwg = nM * nN; G = G_; c = c_; }
    __device__ bool next(int i, Unit& u) const {
        const long L = (long)i * G + c; if (L >= nwg) return false;
        int wgid = (int)L; { const int q = nwg / NXCD, r = nwg % NXCD, xcd = wgid % NXCD, off = wgid / NXCD; wgid = (xcd < r ? xcd * (q + 1) : r * (q + 1) + (xcd - r) * q) + off; }
        const int nig = WGM * nN, gid = wgid / nig, fm = gid * WGM, gsz = (nM - fm) < WGM ? (nM - fm) : WGM;
        u.pm = fm + ((wgid % nig) % gsz); u.pn = (wgid % nig) / gsz; return true;
    }
};

template <class Epi>
__device__ __forceinline__ void gemm_phase(LAS unsigned char* lds, const Gemm g, const StaticOrder& S, const Epi& E) {
    int tid_ = threadIdx.x; asm volatile("" : "+v"(tid_));
    const int tid = tid_, wid = __builtin_amdgcn_readfirstlane(tid >> 6), lane = tid & 63, wr = wid >> 2, wc = wid & 3, fr = lane & 15, fq = lane >> 4;
    const int K = g.K, nt = K / BK;
    unsigned voffA[2], voffB[2];
#pragma unroll
    for (int i = 0; i < 2; ++i) { int R, C; stage_rc(tid * 16 + i * 8192, R, C); const int Rb = (R & ~31) + perm32(R & 31);
        voffA[i] = (unsigned)(R * g.lda + C) * 2u; voffB[i] = (unsigned)(Rb * K + C) * 2u; }
    const size_t kstep = (size_t)(BK * 2);
    const size_t hstepA = (size_t)HALF * g.lda * 2, hstepB = (size_t)HALF * K * 2;
    const size_t tstepA = 2 * hstepA, tstepB = 2 * hstepB;
    const unsigned ldsw = (unsigned)wid * 1024u;
    const int aoff = lds_byte(wr * 64 + fr, fq * 8), boff = lds_byte(wc * 32 + fr, fq * 8);
#define PG8_SA(b, h) (((b) * 2 + (h)) * HTB)
#define PG8_SB(b, h) ((4 + (b) * 2 + (h)) * HTB)
#define PG8_STAGE(bufoff, gbase, voff) do { _Pragma("unroll") for (int _i = 0; _i < 2; ++_i) \
        __builtin_amdgcn_global_load_lds((const unsigned*)((const char*)(gbase) + (voff)[_i]), (LAS unsigned*)(lds + (bufoff) + ldsw + _i * 8192), 16, 0, 0); } while (0)
#define PG8_LDA(dst, b, h) do { _Pragma("unroll") for (int m = 0; m < 4; ++m) _Pragma("unroll") for (int k = 0; k < 2; ++k) dst[m][k] = *(const LAS bf16x8*)(lds + PG8_SA(b, h) + aoff + m * 2048 + k * 1024); } while (0)
#define PG8_LDB(dst, b, h) do { _Pragma("unroll") for (int n = 0; n < 2; ++n) _Pragma("unroll") for (int k = 0; k < 2; ++k) dst[n][k] = *(const LAS bf16x8*)(lds + PG8_SB(b, h) + boff + n * 2048 + k * 1024); } while (0)
#define PG8_MMA(ai, bj, At, Bt) do { __builtin_amdgcn_s_setprio(1); _Pragma("unroll") for (int m = 0; m < 4; ++m) _Pragma("unroll") for (int n = 0; n < 2; ++n) _Pragma("unroll") for (int k = 0; k < 2; ++k) \
        acc[ai][bj][m][n] = __builtin_amdgcn_mfma_f32_16x16x32_bf16(Bt[n][k], At[m][k], acc[ai][bj][m][n], 0, 0, 0); __builtin_amdgcn_s_setprio(0); } while (0)
#define PG8_WAIT_V(n) asm volatile("s_waitcnt vmcnt(" #n ")" ::: "memory")
#define PG8_WAIT_L(n) asm volatile("s_waitcnt lgkmcnt(" #n ")" ::: "memory")
#define PG8_BAR __builtin_amdgcn_s_barrier()
#define PG8_SCHED __builtin_amdgcn_sched_barrier(0)
    Unit cur, nxt; int ui = 0;
    if (!S.next(0, cur)) return;
    f32x4 acc[2][2][4][2];
#pragma unroll
    for (int a = 0; a < 2; ++a)
#pragma unroll
        for (int b = 0; b < 2; ++b)
#pragma unroll
            for (int m = 0; m < 4; ++m)
#pragma unroll
                for (int n = 0; n < 2; ++n) acc[a][b][m][n] = (f32x4){0.f, 0.f, 0.f, 0.f};
    bf16x8 At[4][2], B0[2][2], B1[2][2];
    const char* cA = (const char*)g.A + (size_t)cur.pm * tstepA + (size_t)cur.pn * g.apn; const char* cB = (const char*)g.Bt + (size_t)cur.pn * tstepB;
    PG8_STAGE(PG8_SB(0, 0), cB, voffB); PG8_STAGE(PG8_SA(0, 0), cA, voffA); PG8_STAGE(PG8_SB(0, 1), cB + hstepB, voffB); PG8_STAGE(PG8_SA(0, 1), cA + hstepA, voffA);
    if (wr == 1) PG8_BAR;
    PG8_WAIT_V(4); PG8_BAR;
    PG8_STAGE(PG8_SB(1, 0), cB + kstep, voffB); PG8_STAGE(PG8_SA(1, 0), cA + kstep, voffA); PG8_STAGE(PG8_SB(1, 1), cB + hstepB + kstep, voffB);
    PG8_WAIT_V(6); PG8_BAR;
    for (;;) {
        const bool has_next = S.next(ui + 1, nxt);
        const char* nA = has_next ? (const char*)g.A + (size_t)nxt.pm * tstepA + (size_t)nxt.pn * g.apn : cA; const char* nB = has_next ? (const char*)g.Bt + (size_t)nxt.pn * tstepB : cB;
        for (int t = 0; t < nt; t += 2) {
            const bool last = (t == nt - 2);
            const char* a1 = cA + (size_t)(t + 1) * kstep;
            const char* a2 = last ? nA : cA + (size_t)(t + 2) * kstep; const char* b2 = last ? nB : cB + (size_t)(t + 2) * kstep;
            const char* a3 = a2 + kstep; const char* b3 = b2 + kstep;
            PG8_LDB(B0, 0, 0); PG8_SCHED; PG8_LDA(At, 0, 0); PG8_STAGE(PG8_SA(1, 1), a1 + hstepA, voffA);
            PG8_WAIT_L(8); PG8_BAR; PG8_WAIT_L(0); PG8_MMA(0, 0, At, B0); PG8_BAR; PG8_SCHED;
            PG8_LDB(B1, 0, 1); PG8_STAGE(PG8_SB(0, 0), b2, voffB);
            PG8_BAR; PG8_WAIT_L(0); PG8_MMA(0, 1, At, B1); PG8_BAR;
            PG8_LDA(At, 0, 1); PG8_STAGE(PG8_SA(0, 0), a2, voffA);
            PG8_BAR; PG8_WAIT_L(0); PG8_MMA(1, 0, At, B0); PG8_BAR; PG8_SCHED;
            PG8_STAGE(PG8_SB(0, 1), b2 + hstepB, voffB);
            PG8_WAIT_V(6); PG8_BAR; PG8_MMA(1, 1, At, B1); PG8_BAR;
            PG8_LDB(B0, 1, 0); PG8_SCHED; PG8_LDA(At, 1, 0); PG8_STAGE(PG8_SA(0, 1), a2 + hstepA, voffA);
            PG8_WAIT_L(8); PG8_BAR; PG8_WAIT_L(0); PG8_MMA(0, 0, At, B0); PG8_BAR; PG8_SCHED;
            PG8_LDB(B1, 1, 1); PG8_STAGE(PG8_SB(1, 0), b3, voffB);
            PG8_BAR; PG8_WAIT_L(0); PG8_MMA(0, 1, At, B1); PG8_BAR;
            PG8_LDA(At, 1, 1); PG8_STAGE(PG8_SA(1, 0), a3, voffA);
            PG8_BAR; PG8_WAIT_L(0); PG8_MMA(1, 0, At, B0); PG8_BAR; PG8_SCHED;
            PG8_STAGE(PG8_SB(1, 1), b3 + hstepB, voffB);
            PG8_WAIT_V(6); PG8_BAR; PG8_MMA(1, 1, At, B1); PG8_BAR;
        }
        E(acc, cur, wr, wc, fr, fq);
        if (!has_next) break;
#pragma unroll
        for (int a = 0; a < 2; ++a)
#pragma unroll
            for (int b = 0; b < 2; ++b)
#pragma unroll
                for (int m = 0; m < 4; ++m)
#pragma unroll
                    for (int n = 0; n < 2; ++n) acc[a][b][m][n] = (f32x4){0.f, 0.f, 0.f, 0.f};
        cur = nxt; cA = nA; cB = nB; ++ui;
    }
    PG8_WAIT_V(0);
    if (wr == 0) PG8_BAR;
    PG8_BAR;
#undef PG8_SA
#undef PG8_SB
#undef PG8_STAGE
#undef PG8_LDA
#undef PG8_LDB
#undef PG8_MMA
#undef PG8_WAIT_V
#undef PG8_WAIT_L
#undef PG8_BAR
#undef PG8_SCHED
}
}

enum { E_RES_IN = 0, E_RES_LN = 1, E_SWIGLU = 2, E_GDN = 3, E_RET = 4 };
template <int MODE> struct Epi {
    const float* st_in; const float* c1; const float* c2;
    const float* xp; const float* xs;
    const bf16_t* yprev; const float* lg; const float* lb;
    const float* cscale;
    float* st_out; bf16_t* yout;
    bf16_t* ob; float* of; const float* rope;
    __device__ __forceinline__ void operator()(const f32x4 (&acc)[2][2][4][2], const pg8::Unit& u, int wr, int wc, int fr, int fq) const {
        const int rowb = u.pm * 256 + wr * 64 + fr;
        const int colb = u.pn * 256 + wc * 32 + 8 * fq;
#pragma unroll
        for (int ai = 0; ai < 2; ++ai)
#pragma unroll
            for (int m = 0; m < 4; ++m) {
                const int r = rowb + ai * 128 + m * 16;
                float mu = 0.f, rstd = 1.f;
                if constexpr (MODE != E_RES_IN) ln_stats4(st_in, r, fq, mu, rstd);
                if constexpr (MODE < 2) {
                    float s = 0.f, q = 0.f;
#pragma unroll
                    for (int bj = 0; bj < 2; ++bj) {
                        const int c0 = colb + bj * 128;
                        f32x4 x0, x1;
                        if constexpr (MODE == E_RES_IN) {
                            const float* src = (u.pm < MPR / 256 ? xp + (size_t)r * D : xs + (size_t)(r - MPR < NS ? r - MPR : NS - 1) * D);
                            x0 = *(const f32x4*)(src + c0); x1 = *(const f32x4*)(src + c0 + 4);
                        } else {
                            const u32x4 w = *(const u32x4*)(yprev + (size_t)r * D + c0);
                            x0 = (f32x4){bf_lo(w.x), bf_hi(w.x), bf_lo(w.y), bf_hi(w.y)}; x1 = (f32x4){bf_lo(w.z), bf_hi(w.z), bf_lo(w.w), bf_hi(w.w)};
                            x0 = (x0 - mu) * rstd * *(const f32x4*)(lg + c0) + *(const f32x4*)(lb + c0); x1 = (x1 - mu) * rstd * *(const f32x4*)(lg + c0 + 4) + *(const f32x4*)(lb + c0 + 4);
                        }
                        f32x4 a0 = acc[ai][bj][m][0], a1 = acc[ai][bj][m][1];
                        if (cscale) { a0 *= *(const f32x4*)(cscale + c0); a1 *= *(const f32x4*)(cscale + c0 + 4); }
                        const f32x4 y0 = x0 * DN_ALPHA + a0, y1 = x1 * DN_ALPHA + a1;
                        u32x4 o; o.x = cvt_pk_bf16(y0[0], y0[1]); o.y = cvt_pk_bf16(y0[2], y0[3]); o.z = cvt_pk_bf16(y1[0], y1[1]); o.w = cvt_pk_bf16(y1[2], y1[3]);
                        *(u32x4*)(yout + (size_t)r * D + c0) = o;
                        s += (y0[0] + y0[1]) + (y0[2] + y0[3]) + (y1[0] + y1[1]) + (y1[2] + y1[3]);
                        q += (y0[0] * y0[0] + y0[1] * y0[1]) + (y0[2] * y0[2] + y0[3] * y0[3]) + (y1[0] * y1[0] + y1[1] * y1[1]) + (y1[2] * y1[2] + y1[3] * y1[3]);
                    }
                    s += __shfl_xor(s, 16); s += __shfl_xor(s, 32); q += __shfl_xor(q, 16); q += __shfl_xor(q, 32);
                    if (fq == 0) *(f32x2*)(st_out + 32 * (size_t)r + 2 * (u.pn * 4 + wc)) = (f32x2){s, q};
                } else {
#pragma unroll
                    for (int bj = 0; bj < 2; ++bj) {
                        const int c0 = colb + bj * 128;
                        const f32x4 h0 = (acc[ai][bj][m][0] - *(const f32x4*)(c1 + c0) * mu) * rstd + *(const f32x4*)(c2 + c0), h1 = (acc[ai][bj][m][1] - *(const f32x4*)(c1 + c0 + 4) * mu) * rstd + *(const f32x4*)(c2 + c0 + 4);
                        if constexpr (MODE == E_SWIGLU) {
                            u32x2 o; o.x = cvt_pk_bf16(fsilu(h0[0]) * h0[1], fsilu(h0[2]) * h0[3]); o.y = cvt_pk_bf16(fsilu(h1[0]) * h1[1], fsilu(h1[2]) * h1[3]);
                            *(u32x2*)(ob + (size_t)r * DFF + (c0 >> 1)) = o;
                        } else if constexpr (MODE == E_GDN) {
                            if (c0 < 4096) {
                                u32x4 o; o.x = cvt_pk_bf16(h0[0], h0[1]); o.y = cvt_pk_bf16(h0[2], h0[3]); o.z = cvt_pk_bf16(h1[0], h1[1]); o.w = cvt_pk_bf16(h1[2], h1[3]);
                                *(u32x4*)(ob + (size_t)r * 4096 + c0) = o;
                            } else if (c0 < GIN) {
                                *(f32x4*)(of + (size_t)r * 16 + (c0 - 4096)) = h0; *(f32x4*)(of + (size_t)r * 16 + (c0 - 4096) + 4) = h1;
                            }
                        } else {
                            if (u.pn < 8) {
                                const int pidx = r < MPR ? (r & (T - 1)) : T;
                                const int hb = c0 & ~127, i0 = (c0 & 127) >> 1;
                                const f32x4 t0 = *(const f32x4*)(rope + ((size_t)pidx * 64 + i0) * 2), t1 = *(const f32x4*)(rope + ((size_t)pidx * 64 + i0) * 2 + 4);
                                const float sc = c0 >= 1024 ? 0.088388347648318f : 1.0f;
                                const float a0 = (h0[0] * t0[0] - h0[1] * t0[1]) * sc, a1 = (h0[2] * t0[2] - h0[3] * t0[3]) * sc, a2 = (h1[0] * t1[0] - h1[1] * t1[1]) * sc, a3 = (h1[2] * t1[2] - h1[3] * t1[3]) * sc;
                                const float e0 = (h0[0] * t0[1] + h0[1] * t0[0]) * sc, e1 = (h0[2] * t0[3] + h0[3] * t0[2]) * sc, e2 = (h1[0] * t1[1] + h1[1] * t1[0]) * sc, e3 = (h1[2] * t1[3] + h1[3] * t1[2]) * sc;
                                u32x2 o1, o2; o1.x = cvt_pk_bf16(a0, a1); o1.y = cvt_pk_bf16(a2, a3); o2.x = cvt_pk_bf16(e0, e1); o2.y = cvt_pk_bf16(e2, e3);
                                *(u32x2*)(ob + (size_t)r * RIN + hb + i0) = o1; *(u32x2*)(ob + (size_t)r * RIN + hb + 64 + i0) = o2;
                            } else {
                                u32x4 o; o.x = cvt_pk_bf16(h0[0], h0[1]); o.y = cvt_pk_bf16(h0[2], h0[3]); o.z = cvt_pk_bf16(h1[0], h1[1]); o.w = cvt_pk_bf16(h1[2], h1[3]);
                                *(u32x4*)(ob + (size_t)r * RIN + c0) = o;
                            }
                        }
                    }
                }
                asm volatile("" ::: "memory");
            }
    }
};

template <int MAP  >
__device__ __forceinline__ int map_col(int j) {
    if (MAP == 1) return 2 * (j % DFF) + (j / DFF);
    if (MAP == 2) { if (j < 2048) { const int hb = j & ~127, d = j & 127; return hb + 2 * (d & 63) + (d >> 6); } }
    return j;
}
template <int MAP>
__device__ __forceinline__ void transpose_tile(int tid, LAS float* tile, const float* __restrict__ src, int Nsrc, int K, int k0, int j0, bf16_t* __restrict__ dst,
                                               const float* __restrict__ g, const float* __restrict__ b, float& s1, float& s2) {
#pragma unroll
    for (int p = 0; p < 2; ++p) {
        const int idx = tid + p * 512, kk = idx >> 4, j4 = (idx & 15) * 4;
        f32x4 v = (f32x4){0.f, 0.f, 0.f, 0.f};
        if (j0 + j4 < Nsrc) v = *(const f32x4*)(src + (size_t)(k0 + kk) * Nsrc + j0 + j4);
        tile[kk * 65 + j4 + 0] = v[0]; tile[kk * 65 + j4 + 1] = v[1]; tile[kk * 65 + j4 + 2] = v[2]; tile[kk * 65 + j4 + 3] = v[3];
    }
    __syncthreads();
    const int jj = tid >> 3, kc = tid & 7, j = j0 + jj;
    const int n = map_col<MAP>(j);
    unsigned w[4];
#pragma unroll
    for (int e = 0; e < 4; ++e) {
        const int ka = kc * 8 + 2 * e;
        const float v0 = tile[ka * 65 + jj], v1 = tile[(ka + 1) * 65 + jj];
        float g0 = 1.f, g1 = 1.f;
        if (g) { g0 = g[k0 + ka]; g1 = g[k0 + ka + 1]; }
        w[e] = cvt_pk_bf16(v0 * g0, v1 * g1);
        if (g) { s1 += bf_lo(w[e]) + bf_hi(w[e]); s2 += b[k0 + ka] * v0 + b[k0 + ka + 1] * v1; }
    }
    if (j < Nsrc) { u32x4 o; o.x = w[0]; o.y = w[1]; o.z = w[2]; o.w = w[3]; *(u32x4*)(dst + (size_t)n * K + k0 + kc * 8) = o; }
    __syncthreads();
}
template <int MAP>
__device__ __forceinline__ void fold_strip(int tid, LAS float* tile, const float* __restrict__ src, int Nsrc, int j0, bf16_t* __restrict__ dst,
                                           const float* __restrict__ g, const float* __restrict__ b, float* c1, float* c2) {
    float s1 = 0.f, s2 = 0.f;
    for (int kt = 0; kt < 16; ++kt) transpose_tile<MAP>(tid, tile, src, Nsrc, 1024, kt * 64, j0, dst, g, b, s1, s2);
    s1 += __shfl_xor(s1, 1); s1 += __shfl_xor(s1, 2); s1 += __shfl_xor(s1, 4);
    s2 += __shfl_xor(s2, 1); s2 += __shfl_xor(s2, 2); s2 += __shfl_xor(s2, 4);
    const int j = j0 + (tid >> 3);
    if ((tid & 7) == 0 && j < Nsrc) { const int n = map_col<MAP>(j); c1[n] = s1; c2[n] = s2; }
}

template <int LAYER>
__device__ __forceinline__ f32x2 pool_x(const float* xin, const bf16_t* y, const float* st, const f32x2 g2, const f32x2 b2, int r, int c) {
    if constexpr (LAYER == 0) { return *(const f32x2*)(xin + (size_t)r * D + c); }
    else { float mu, rstd; ln_stats(st, r, mu, rstd); const unsigned w = *(const unsigned*)(y + (size_t)r * D + c); f32x2 v; v.x = (bf_lo(w) - mu) * rstd * g2.x + b2.x; v.y = (bf_hi(w) - mu) * rstd * g2.y + b2.y; return v; }
}
template <int LAYER>
__device__ void pool_stencil_phase(const Ctx& p, int li  , const bf16_t* y, const float* st, const float* lg, const float* lb, bf16_t* apool) {
    const int tid = opaque_tid(), c = tid * 2;
    const int win = 2 << (c >> 8);
    f32x2 g2 = (f32x2){1.f, 1.f}, b2 = (f32x2){0.f, 0.f};
    if constexpr (LAYER != 0) { g2 = *(const f32x2*)(lg + c); b2 = *(const f32x2*)(lb + c); }
    const float* xp = p.in(0);
    float* out = p.out();
    for (int item = blockIdx.x; item < NB * 64; item += gridDim.x) {
        const int b = item >> 6, t0 = (item & 63) * 32, rb = b * T;
        f32x2 s = (f32x2){0.f, 0.f};
        for (int j = 1; j < win; ++j) if (t0 - j >= 0) { const f32x2 v = pool_x<LAYER>(xp, y, st, g2, b2, rb + t0 - j, c); s += v; }
        for (int t = t0; t < t0 + 32; ++t) {
            const f32x2 xv = pool_x<LAYER>(xp, y, st, g2, b2, rb + t, c);
            s += xv;
            const float inv = 1.0f / (float)(t + 1 < win ? t + 1 : win);
            const f32x2 pv = s * inv - xv;
            *(unsigned*)(apool + (size_t)(rb + t) * D + c) = cvt_pk_bf16(pv.x, pv.y);
            if (t >= T - PBUF) *(f32x2*)(out + O_PP + ((size_t)(li * NB + b) * PBUF + (t - (T - PBUF))) * D + c) = xv;
            if (t - win + 1 >= 0) { const f32x2 v = pool_x<LAYER>(xp, y, st, g2, b2, rb + t - win + 1, c); s -= v; }
        }
    }
    const float* spool = p.in(2) + (size_t)li * NS * PBUF * D;
    for (int i = blockIdx.x; i < NS; i += gridDim.x) {
        f32x2 xv;
        if constexpr (LAYER == 0) xv = *(const f32x2*)(p.in(1) + (size_t)i * D + c); else xv = pool_x<LAYER>(nullptr, y, st, g2, b2, MPR + i, c);
        f32x2 s = xv;
        for (int j = 1; j < win; ++j) s += *(const f32x2*)(spool + ((size_t)i * PBUF + (PBUF - j)) * D + c);
        const f32x2 pv = s * (1.0f / (float)win) - xv;
        *(unsigned*)(apool + (size_t)(MPR + i) * D + c) = cvt_pk_bf16(pv.x, pv.y);
        float* dst = out + O_PS + ((size_t)(li * NS + i) * PBUF) * D + c;
        for (int q = 0; q < PBUF - 1; ++q) *(f32x2*)(dst + (size_t)q * D) = *(const f32x2*)(spool + ((size_t)i * PBUF + q + 1) * D + c);
        *(f32x2*)(dst + (size_t)(PBUF - 1) * D) = xv;
    }
}

__device__ void prep_phase(const Ctx& p, LAS unsigned char* lds) {
    LAS float* tile = (LAS float*)lds;
    unsigned char* ws = p.ws();
    const int G = gridDim.x, bid = blockIdx.x, tid = opaque_tid();
    float* c1 = (float*)(ws + WS_C1); float* c2 = (float*)(ws + WS_C2);
    const float* ln_g = p.in(18); const float* ln_b = p.in(19);
    float d1 = 0.f, d2 = 0.f;
    for (int t = bid; t < 4 * 88 + 65 + 96; t += G) {
        if (t < 352) { const int mi = t / 88, jt = t % 88;
            fold_strip<1>(tid, tile, p.in(16) + (size_t)mi * 1024 * 5632, 5632, jt * 64, (bf16_t*)(ws + WS_W13) + (size_t)mi * 5632 * 1024, ln_g + (size_t)(mi * 2) * D, ln_b + (size_t)(mi * 2) * D, c1 + mi * 5632, c2 + mi * 5632); }
        else if (t < 352 + 65) { fold_strip<0>(tid, tile, p.in(8), GIN, (t - 352) * 64, (bf16_t*)(ws + WS_WGI), ln_g + 1 * D, ln_b + 1 * D, c1 + 4 * 5632, c2 + 4 * 5632); }
        else { fold_strip<2>(tid, tile, p.in(14), RIN, (t - 417) * 64, (bf16_t*)(ws + WS_WRI), ln_g + 3 * D, ln_b + 3 * D, c1 + 4 * 5632 + GINP, c2 + 4 * 5632 + GINP); }
    }
    for (int t = bid; t < 8 * 16; t += G) { const int mi = t >> 4, tt = t & 15;
        transpose_tile<0>(tid, tile, p.in(6) + (size_t)mi * 65536, 256, 256, (tt >> 2) * 64, (tt & 3) * 64, (bf16_t*)(ws + WS_WPOOL) + (size_t)mi * 65536, nullptr, nullptr, d1, d2); }
    for (int t = bid; t < 4 * 44 * 16; t += G) { const int mi = t / 704, tt = t % 704, kt = tt / 16, jt = tt % 16;
        transpose_tile<0>(tid, tile, p.in(17) + (size_t)mi * 2816 * 1024, 1024, 2816, kt * 64, jt * 64, (bf16_t*)(ws + WS_W2) + (size_t)mi * 1024 * 2816, nullptr, nullptr, d1, d2); }
    for (int t = bid; t < 16 * 16; t += G) { const int kt = t / 16, jt = t % 16;
        transpose_tile<0>(tid, tile, p.in(13), 1024, 1024, kt * 64, jt * 64, (bf16_t*)(ws + WS_WGO), nullptr, nullptr, d1, d2); }
    for (int t = bid; t < 32 * 16; t += G) { const int kt = t / 16, jt = t % 16;
        transpose_tile<0>(tid, tile, p.in(15), 1024, 2048, kt * 64, jt * 64, (bf16_t*)(ws + WS_WRO), nullptr, nullptr, d1, d2); }
    for (size_t i = (size_t)bid * 512 + tid; i < (size_t)(GINP - GIN) * 1024 / 8; i += (size_t)G * 512) ((u32x4*)((bf16_t*)(ws + WS_WGI) + (size_t)GIN * 1024))[i] = (u32x4){0u, 0u, 0u, 0u};
    float* rope = (float*)(ws + WS_ROPE);
    for (int e = bid * 512 + tid; e < 2049 * 64; e += G * 512) {
        const int i = e & 63, pi = e >> 6; const double pos = pi < T ? (double)pi : 16384.0;
        const double freq = exp(-(double)i * (9.210340371976184 / 64.0));
        const double rev = pos * freq * 0.15915494309189535; const float fr = (float)(rev - floor(rev));
        rope[2 * e] = __builtin_amdgcn_cosf(fr); rope[2 * e + 1] = __builtin_amdgcn_sinf(fr);
    }
    pool_stencil_phase<0>(p, 0, nullptr, nullptr, nullptr, nullptr, (bf16_t*)(ws + WS_O));
}

__device__ void gdn_scan_phase(const Ctx& p, LAS unsigned char* lds) {
    constexpr int TB = 32;
    unsigned char* ws = p.ws();
    const bf16_t* PROJ = (const bf16_t*)(ws + WS_BIG); const float* PROJS = (const float*)(ws + WS_PROJS); bf16_t* O = (bf16_t*)(ws + WS_O);
    LAS float* qs = (LAS float*)lds; LAS float* ks = qs + TB * 128; LAS float* vs = ks + TB * 128; LAS float* ob = vs + TB * 128; LAS float* sc = ob + TB * 128;
    const int tid = opaque_tid(), lane = tid & 63, wid = tid >> 6, col = wid * 16 + (lane & 15), kq = lane >> 4, d0 = kq * 32;
    const int G = gridDim.x, bid = blockIdx.x;
    const float* convw = p.in(9); const float* sconv = p.in(3); const float* norm_g = p.in(12);
    const int n_items = 64 + NS * 8;
    int it, istep;
    if (G > 64) { if (bid < 64) { it = bid; istep = n_items; } else { it = 64 + (bid - 64); istep = G - 64; } } else { it = bid; istep = G; }
    for (; it < n_items; it += istep) {
        const bool sample = it >= 64;
        const int h = sample ? ((it - 64) & 7) : (it & 7), sq = sample ? ((it - 64) >> 3) : (it >> 3);
        const int Tn = sample ? 1 : T, r0 = sample ? MPR + sq : sq * T;
        float S[32];
        if (sample) { const float* s0 = p.in(4) + ((size_t)(sq * 8 + h) * 128 + d0) * 128 + col;
#pragma unroll
            for (int dd = 0; dd < 32; ++dd) S[dd] = s0[(size_t)dd * 128]; }
        else {
#pragma unroll
            for (int dd = 0; dd < 32; ++dd) S[dd] = 0.f; }
        const float Aneg = -__expf(p.in(10)[h]), dtb = p.in(11)[h];
        for (int tb = 0; tb < Tn; tb += TB) {
            const int nb = (Tn - tb) < TB ? (Tn - tb) : TB;
            for (int idx = tid; idx < nb * 384; idx += 512) {
                const int tt = idx / 384, ch = idx - tt * 384, part = ch >> 7, dd = ch & 127, gch = part * 1024 + h * 128 + dd, t = tb + tt;
                float a = 0.f;
#pragma unroll
                for (int j = 0; j < 4; ++j) { const int tp = t - 3 + j; float uv = 0.f;
                    if (tp >= 0) uv = bf2f(PROJ[(size_t)(r0 + tp) * 4096 + gch]); else if (sample) uv = sconv[((size_t)sq * 3 + (3 + tp)) * CCH + gch];
                    a += convw[j * CCH + gch] * uv; }
                const float val = fsilu(a);
                (part == 0 ? qs : (part == 1 ? ks : vs))[tt * 128 + dd] = val;
            }
            if (tid < nb) { const int r = r0 + tb + tid; const float bl = PROJS[(size_t)r * 16 + h], ai = PROJS[(size_t)r * 16 + 8 + h];
                const float x = ai + dtb; const float sp = x > 20.f ? x : log1pf(__expf(x));
                sc[tid] = fsigmoid(bl); sc[TB + tid] = __expf(Aneg * sp); }
            __syncthreads();
            for (int tt = wid; tt < nb; tt += 8) {
                float q0 = qs[tt * 128 + lane], q1 = qs[tt * 128 + 64 + lane], k0 = ks[tt * 128 + lane], k1 = ks[tt * 128 + 64 + lane];
                const float sq2 = wave_sum(q0 * q0 + q1 * q1), sk2 = wave_sum(k0 * k0 + k1 * k1);
                const float qn = rsqrtf(sq2 + RMS_EPS) * 0.088388347648318f, kn = rsqrtf(sk2 + RMS_EPS);
                q0 *= qn; q1 *= qn; k0 *= kn; k1 *= kn;
                qs[tt * 128 + lane] = q0; qs[tt * 128 + 64 + lane] = q1; ks[tt * 128 + lane] = k0; ks[tt * 128 + 64 + lane] = k1;
                const float dt = wave_sum(q0 * k0 + q1 * k1);
                if (lane == 0) sc[2 * TB + tt] = dt;
            }
            __syncthreads();
            for (int tt = 0; tt < nb; ++tt) {
                f32x4 kr[8], qr[8];
#pragma unroll
                for (int e = 0; e < 8; ++e) { kr[e] = *(const LAS f32x4*)(ks + tt * 128 + d0 + 4 * e); qr[e] = *(const LAS f32x4*)(qs + tt * 128 + d0 + 4 * e); }
                float rp = 0.f, pp = 0.f;
#pragma unroll
                for (int e = 0; e < 8; ++e)
#pragma unroll
                    for (int j = 0; j < 4; ++j) { rp += kr[e][j] * S[4 * e + j]; pp += qr[e][j] * S[4 * e + j]; }
                rp += __shfl_xor(rp, 16); rp += __shfl_xor(rp, 32); pp += __shfl_xor(pp, 16); pp += __shfl_xor(pp, 32);
                const float beta = sc[tt], a = sc[TB + tt], qk = sc[2 * TB + tt], v = vs[tt * 128 + col];
                const float vnew = beta * (v - a * rp);
#pragma unroll
                for (int e = 0; e < 8; ++e)
#pragma unroll
                    for (int j = 0; j < 4; ++j) S[4 * e + j] = a * S[4 * e + j] + kr[e][j] * vnew;
                if (kq == 0) ob[tt * 128 + col] = a * pp + qk * vnew;
            }
            __syncthreads();
            for (int tt = wid; tt < nb; tt += 8) {
                const int r = r0 + tb + tt;
                const float o0 = ob[tt * 128 + lane], o1 = ob[tt * 128 + 64 + lane];
                const float rn = rsqrtf(wave_sum(o0 * o0 + o1 * o1) * (1.0f / 128.0f) + RMS_EPS);
                const float z0 = bf2f(PROJ[(size_t)r * 4096 + 3072 + h * 128 + lane]), z1 = bf2f(PROJ[(size_t)r * 4096 + 3072 + h * 128 + 64 + lane]);
                O[(size_t)r * D + h * 128 + lane] = f2bf(o0 * rn * norm_g[lane] * fsilu(z0));
                O[(size_t)r * D + h * 128 + 64 + lane] = f2bf(o1 * rn * norm_g[64 + lane] * fsilu(z1));
            }
            __syncthreads();
        }
        float* dst = p.out() + (sample ? O_GS : O_GP) + ((size_t)(sq * 8 + h) * 128 + d0) * 128 + col;
#pragma unroll
        for (int dd = 0; dd < 32; ++dd) dst[(size_t)dd * 128] = S[dd];
    }
    for (int idx = bid * 512 + tid; idx < NB * 3 * CCH; idx += G * 512) { const int b = idx / (3 * CCH), j = (idx / CCH) % 3, ch = idx % CCH;
        p.out()[O_CP + idx] = bf2f(PROJ[(size_t)(b * T + T - 3 + j) * 4096 + ch]); }
    for (int idx = bid * 512 + tid; idx < NS * 3 * CCH; idx += G * 512) { const int i = idx / (3 * CCH), j = (idx / CCH) % 3, ch = idx % CCH;
        p.out()[O_CS + idx] = j < 2 ? sconv[((size_t)i * 3 + j + 1) * CCH + ch] : bf2f(PROJ[(size_t)(MPR + i) * 4096 + ch]); }
}

__device__ void ret_scan_phase(const Ctx& p, LAS unsigned char* lds) {
    constexpr int TB = 32;
    unsigned char* ws = p.ws();
    const bf16_t* PR = (const bf16_t*)(ws + WS_BIG); bf16_t* O2 = (bf16_t*)(ws + WS_O);
    LAS float* qs = (LAS float*)lds; LAS float* ks = qs + TB * 128; LAS float* vs = ks + TB * 128; LAS float* op = vs + TB * 256;
    const int tid = opaque_tid(), lane = tid & 63, wid = tid >> 6, col = tid & 255, half = tid >> 8, d0 = half * 64;
    const int G = gridDim.x, bid = blockIdx.x;
    const int n_items = 64 + NS * 8;
    int it, istep;
    if (G > 64) { if (bid < 64) { it = bid; istep = n_items; } else { it = 64 + (bid - 64); istep = G - 64; } } else { it = bid; istep = G; }
    for (; it < n_items; it += istep) {
        const bool sample = it >= 64;
        const int h = sample ? ((it - 64) & 7) : (it & 7), sq = sample ? ((it - 64) >> 3) : (it >> 3);
        const int Tn = sample ? 1 : T, r0 = sample ? MPR + sq : sq * T;
        const float gamma = 1.0f - exp2f(-5.0f - (float)h);
        float S[64];
        if (sample) { const float* s0 = p.in(5) + ((size_t)(sq * 8 + h) * 128 + d0) * 256 + col;
#pragma unroll
            for (int dd = 0; dd < 64; ++dd) S[dd] = s0[(size_t)dd * 256]; }
        else {
#pragma unroll
            for (int dd = 0; dd < 64; ++dd) S[dd] = 0.f; }
        for (int tb = 0; tb < Tn; tb += TB) {
            const int nb = (Tn - tb) < TB ? (Tn - tb) : TB;
            for (int idx = tid; idx < nb * 128; idx += 512) { const int tt = idx >> 7, d = idx & 127; const size_t rb = (size_t)(r0 + tb + tt) * RIN;
                qs[idx] = bf2f(PR[rb + h * 128 + d]); ks[idx] = bf2f(PR[rb + 1024 + h * 128 + d]); }
            for (int idx = tid; idx < nb * 256; idx += 512) { const int tt = idx >> 8, c = idx & 255; vs[idx] = bf2f(PR[(size_t)(r0 + tb + tt) * RIN + 2048 + h * 256 + c]); }
            __syncthreads();
            for (int tt = 0; tt < nb; ++tt) {
                const float v = vs[tt * 256 + col]; float o = 0.f;
#pragma unroll
                for (int e = 0; e < 16; ++e) {
                    const f32x4 kr = *(const LAS f32x4*)(ks + tt * 128 + d0 + 4 * e), qr = *(const LAS f32x4*)(qs + tt * 128 + d0 + 4 * e);
#pragma unroll
                    for (int j = 0; j < 4; ++j) { S[4 * e + j] = gamma * S[4 * e + j] + kr[j] * v; o += qr[j] * S[4 * e + j]; }
                }
                op[(tt * 2 + half) * 256 + col] = o;
            }
            __syncthreads();
            for (int tt = wid; tt < nb; tt += 8) {
                const size_t rb = (size_t)(r0 + tb + tt);
                float o[4]; float s = 0.f;
#pragma unroll
                for (int j = 0; j < 4; ++j) { o[j] = op[(tt * 2) * 256 + lane + 64 * j] + op[(tt * 2 + 1) * 256 + lane + 64 * j]; s += o[j]; }
                const float mean = wave_sum(s) * (1.0f / 256.0f);
                float q = 0.f;
#pragma unroll
                for (int j = 0; j < 4; ++j) { o[j] -= mean; q += o[j] * o[j]; }
                const float rs = rsqrtf(wave_sum(q) * (1.0f / 256.0f) + LN_EPS);
#pragma unroll
                for (int j = 0; j < 4; ++j) { const float gt = bf2f(PR[rb * RIN + 4096 + h * 256 + lane + 64 * j]); O2[rb * 2048 + h * 256 + lane + 64 * j] = f2bf(fsilu(gt) * o[j] * rs); }
            }
            __syncthreads();
        }
        float* dst = p.out() + (sample ? O_RS : O_RP) + ((size_t)(sq * 8 + h) * 128 + d0) * 256 + col;
#pragma unroll
        for (int dd = 0; dd < 64; ++dd) dst[(size_t)dd * 256] = S[dd];
    }
}

__device__ void final_ln_phase(const Ctx& p, const bf16_t* y, const float* st, const float* lg, const float* lb) {
    const int tid = opaque_tid();
    for (size_t e = (size_t)blockIdx.x * 512 + tid; e < (size_t)MR * (D / 8); e += (size_t)gridDim.x * 512) {
        const int r = (int)(e >> 7), c0 = (int)(e & 127) * 8;
        float mu, rstd; ln_stats(st, r, mu, rstd);
        const u32x4 w = *(const u32x4*)(y + (size_t)r * D + c0);
        f32x4 x0 = (f32x4){bf_lo(w.x), bf_hi(w.x), bf_lo(w.y), bf_hi(w.y)}, x1 = (f32x4){bf_lo(w.z), bf_hi(w.z), bf_lo(w.w), bf_hi(w.w)};
        x0 = (x0 - mu) * rstd * *(const f32x4*)(lg + c0) + *(const f32x4*)(lb + c0);
        x1 = (x1 - mu) * rstd * *(const f32x4*)(lg + c0 + 4) + *(const f32x4*)(lb + c0 + 4);
        float* dst = p.out() + (r < MPR ? O_YP + (size_t)r * D : O_YS + (size_t)(r - MPR) * D) + c0;
        *(f32x4*)dst = x0; *(f32x4*)(dst + 4) = x1;
    }
}

__global__ void __launch_bounds__(512, 2) fwd_megakernel(Params kp) {
    extern __shared__ __attribute__((aligned(16))) unsigned char lds_raw[];
    LAS unsigned char* lds = (LAS unsigned char*)lds_raw;
    cg::grid_group grid = cg::this_grid();
    if (threadIdx.x == 0) {
        LAS unsigned long long* tb = (LAS unsigned long long*)(lds + PTAB_OFF);
#pragma unroll
        for (int i = 0; i < 20; ++i) tb[i] = (unsigned long long)kp.in[i];
        tb[20] = (unsigned long long)kp.out; tb[21] = (unsigned long long)kp.ws;
    }
    __syncthreads();
    Ctx p; p.tab = (const LAS unsigned*)(lds + PTAB_OFF);
    int ph0 = kp.ph_lo; bool need_sync = false;
    if (ph0 == 0) { if (EN(0)) prep_phase(p, lds); ph0 = 1; need_sync = true; }
    for (int ph = ph0; ph < kp.ph_hi; ++ph) {
        if (need_sync) grid.sync();
        need_sync = true;
        __syncthreads();
        if (ph == 5) { if (EN(5)) gdn_scan_phase(p, lds); continue; }
        if (ph == 10) { if (EN(10)) ret_scan_phase(p, lds); continue; }
        unsigned char* ws = p.ws();
        float* stats = (float*)(ws + WS_STATS);
        const float* ln_g = p.in(18); const float* ln_b = p.in(19);
#define YBUF(s) ((bf16_t*)(ws + (((s) & 1) ? WS_YB : WS_YA)))
#define STATS(s) (stats + (size_t)(s) * MP * 32)
        if (ph == 14) { if (EN(14)) pool_stencil_phase<3>(p, 1, YBUF(5), STATS(5), ln_g + 5 * D, ln_b + 5 * D, (bf16_t*)(ws + WS_O)); continue; }
        if (ph == 18) { if (EN(18)) final_ln_phase(p, YBUF(7), STATS(7), ln_g + 7 * D, ln_b + 7 * D); continue; }
        const int layer = ph <= 3 ? 0 : (ph <= 8 ? 1 : (ph <= 13 ? 2 : 3));
        int kind, lda = D, K = 1024, nN = 4, apn = 0, sin = 0, sout = 0, coff = 0;
        size_t aoff = WS_O, boff = 0;
        if (ph == 1 || ph == 15) { kind = ph == 1 ? E_RES_IN : E_RES_LN; K = 256; apn = 512; boff = WS_WPOOL + (size_t)(ph == 1 ? 0 : 1) * 4 * 65536 * 2; sin = 5; sout = ph == 1 ? 0 : 6; }
        else if (ph == 2 || ph == 7 || ph == 12 || ph == 16) { kind = E_SWIGLU; sin = 2 * layer; aoff = (sin & 1) ? WS_YB : WS_YA; boff = WS_W13 + (size_t)layer * 5632 * 1024 * 2; nN = 22; coff = layer * 5632; }
        else if (ph == 3 || ph == 8 || ph == 13 || ph == 17) { kind = E_RES_LN; sin = 2 * layer; sout = sin + 1; aoff = WS_BIG; lda = DFF; K = DFF; boff = WS_W2 + (size_t)layer * 1024 * 2816 * 2; }
        else if (ph == 4) { kind = E_GDN; sin = 1; aoff = WS_YB; boff = WS_WGI; nN = GINP / 256; coff = 4 * 5632; }
        else if (ph == 6) { kind = E_RES_LN; sin = 1; sout = 2; boff = WS_WGO; }
        else if (ph == 9) { kind = E_RET; sin = 3; aoff = WS_YB; boff = WS_WRI; nN = RIN / 256; coff = 4 * 5632 + GINP; }
        else   { kind = E_RES_LN; sin = 3; sout = 4; lda = 2048; K = 2048; boff = WS_WRO; }
        pg8::Gemm g{(const bf16_t*)(ws + aoff), (const bf16_t*)(ws + boff), lda, K, MP / 256, nN, apn};
        pg8::StaticOrder S; S.init(g.nM, g.nN, gridDim.x, blockIdx.x);
        if (kind == E_RES_IN) { if (EN(1)) { Epi<E_RES_IN> E{}; E.xp = p.in(0); E.xs = p.in(1); E.cscale = p.in(7); E.st_out = STATS(0); E.yout = YBUF(0); pg8::gemm_phase(lds, g, S, E); } }
        else if (kind == E_RES_LN) { if (EN(3)) { Epi<E_RES_LN> E{}; E.st_in = STATS(sin); E.yprev = YBUF(sin); E.lg = ln_g + (size_t)sin * D; E.lb = ln_b + (size_t)sin * D;
            E.cscale = ph == 15 ? p.in(7) + D : nullptr; E.st_out = STATS(sout); E.yout = YBUF(sout); pg8::gemm_phase(lds, g, S, E); } }
        else {
            const float* c1 = (const float*)(ws + WS_C1) + coff; const float* c2 = (const float*)(ws + WS_C2) + coff;
            if (kind == E_SWIGLU) { if (EN(2)) { Epi<E_SWIGLU> E{}; E.st_in = STATS(sin); E.c1 = c1; E.c2 = c2; E.ob = (bf16_t*)(ws + WS_BIG); pg8::gemm_phase(lds, g, S, E); } }
            else if (kind == E_GDN) { if (EN(4)) { Epi<E_GDN> E{}; E.st_in = STATS(sin); E.c1 = c1; E.c2 = c2; E.ob = (bf16_t*)(ws + WS_BIG); E.of = (float*)(ws + WS_PROJS); pg8::gemm_phase(lds, g, S, E); } }
            else { if (EN(9)) { Epi<E_RET> E{}; E.st_in = STATS(sin); E.c1 = c1; E.c2 = c2; E.ob = (bf16_t*)(ws + WS_BIG); E.rope = (const float*)(ws + WS_ROPE); pg8::gemm_phase(lds, g, S, E); } }
        }
    }
}

extern "C" void kernel_launch(void* const* d_in, const int* in_sizes, int n_in, void* d_out, int out_size, void* d_ws, size_t ws_size, hipStream_t stream) {
    static int grid = 0;
    if (grid == 0) {
        if (n_in != 20 || (size_t)out_size != O_END || ws_size < WS_END) { fprintf(stderr, "kernel_launch: unexpected shapes: n_in %d out %d (want %zu) ws %zu (want %zu)\n", n_in, out_size, (size_t)O_END, ws_size, (size_t)WS_END); grid = -1; return; }
        int dev = 0, cus = 0, per_cu = 0;
        hipGetDevice(&dev); hipDeviceGetAttribute(&cus, hipDeviceAttributeMultiprocessorCount, dev);
        if (hipFuncSetAttribute((const void*)fwd_megakernel, hipFuncAttributeMaxDynamicSharedMemorySize, LDS_BYTES) != hipSuccess) { fprintf(stderr, "kernel_launch: hipFuncSetAttribute failed\n"); grid = -1; return; }
        if (hipOccupancyMaxActiveBlocksPerMultiprocessor(&per_cu, (const void*)fwd_megakernel, 512, LDS_BYTES) != hipSuccess || per_cu < 1) { fprintf(stderr, "kernel_launch: occupancy query says %d\n", per_cu); per_cu = 1; }
        (void)hipGetLastError();
        grid = cus;
        fprintf(stderr, "kernel_launch: cus %d per_cu %d grid %d\n", cus, per_cu, grid);
    }
    if (grid < 0) return;
    Params p{};
    for (int i = 0; i < 20; ++i) p.in[i] = (const float*)d_in[i];
    p.out = (float*)d_out; p.ws = (unsigned char*)d_ws;
#if N_LAUNCHES == 1
    p.ph_lo = 0; p.ph_hi = NPH;
    void* args[] = {&p};
    hipError_t e = hipLaunchCooperativeKernel((const void*)fwd_megakernel, dim3(grid), dim3(512), args, LDS_BYTES, stream);
    if (e != hipSuccess) fprintf(stderr, "cooperative launch failed: %s (grid %d)\n", hipGetErrorString(e), grid);
#else
    for (int ph = 0; ph < NPH; ++ph) {
        p.ph_lo = ph; p.ph_hi = ph + 1;
        hipLaunchKernelGGL(fwd_megakernel, dim3(grid), dim3(512), LDS_BYTES, stream, p);
    }
#endif
}
```

```cpp
#include <hip/hip_runtime.h>
#include <hip/hip_cooperative_groups.h>
#include <cstdio>
namespace cg = cooperative_groups;

#ifndef N_LAUNCHES
#define N_LAUNCHES 1
#endif

#ifndef PH_MASK
#define PH_MASK 0x7ffff
#endif
#define EN(x) (((PH_MASK) >> (x)) & 1)
#define LAS __attribute__((address_space(3)))
typedef unsigned short bf16_t;
typedef short bf16x8 __attribute__((ext_vector_type(8)));
typedef float f32x4 __attribute__((ext_vector_type(4)));
typedef float f32x2 __attribute__((ext_vector_type(2)));
typedef unsigned u32x4 __attribute__((ext_vector_type(4)));
typedef unsigned u32x2 __attribute__((ext_vector_type(2)));

constexpr int D = 1024, NB = 8, T = 2048, MPR = NB * T, NS = 128, MR = MPR + NS, MP = 16640;
constexpr int DFF = 2816, GIN = 4112, GINP = 4352, RIN = 6144, PBUF = 15, CCH = 3072;
constexpr float DN_ALPHA = 1.6817928305074290f;
constexpr float LN_EPS = 1e-5f, RMS_EPS = 1e-6f;
constexpr int NPH = 20;
constexpr int LDS_BYTES = 147456;

constexpr size_t O_YP = 0;
constexpr size_t O_YS = O_YP + (size_t)MPR * D;
constexpr size_t O_PP = O_YS + (size_t)NS * D;
constexpr size_t O_PS = O_PP + (size_t)2 * NB * PBUF * D;
constexpr size_t O_CP = O_PS + (size_t)2 * NS * PBUF * D;
constexpr size_t O_CS = O_CP + (size_t)NB * 3 * CCH;
constexpr size_t O_GP = O_CS + (size_t)NS * 3 * CCH;
constexpr size_t O_GS = O_GP + (size_t)NB * 8 * 128 * 128;
constexpr size_t O_RP = O_GS + (size_t)NS * 8 * 128 * 128;
constexpr size_t O_RS = O_RP + (size_t)NB * 8 * 128 * 256;
constexpr size_t O_END = O_RS + (size_t)NS * 8 * 128 * 256;

constexpr size_t al256(size_t x) { return (x + 255) & ~(size_t)255; }
constexpr size_t WS_STATS = 0;
constexpr size_t NCFOLD = 4 * 5632 + GINP + RIN;
constexpr size_t WS_C1 = al256(WS_STATS + (size_t)8 * MP * 32 * 4);
constexpr size_t WS_C2 = al256(WS_C1 + NCFOLD * 4);
constexpr size_t WS_ZERO_END = al256(WS_C2 + NCFOLD * 4);
constexpr size_t WS_WPOOL = WS_ZERO_END;
constexpr size_t WS_W13 = al256(WS_WPOOL + (size_t)2 * 4 * 256 * 256 * 2);
constexpr size_t WS_W2 = al256(WS_W13 + (size_t)4 * 5632 * 1024 * 2);
constexpr size_t WS_WGI = al256(WS_W2 + (size_t)4 * 1024 * 2816 * 2);
constexpr size_t WS_WGO = al256(WS_WGI + (size_t)GINP * 1024 * 2);
constexpr size_t WS_WRI = al256(WS_WGO + (size_t)1024 * 1024 * 2);
constexpr size_t WS_WRO = al256(WS_WRI + (size_t)RIN * 1024 * 2);
constexpr size_t WS_ROPE = al256(WS_WRO + (size_t)1024 * 2048 * 2);
constexpr size_t WS_YA = al256(WS_ROPE + (size_t)2049 * 64 * 2 * 4);
constexpr size_t WS_YB = al256(WS_YA + (size_t)MP * D * 2);
constexpr size_t WS_O = al256(WS_YB + (size_t)MP * D * 2);
constexpr size_t WS_PROJS = al256(WS_O + (size_t)MP * 2048 * 2);
constexpr size_t WS_BIG = al256(WS_PROJS + (size_t)MP * 16 * 4);
constexpr size_t WS_GAT = al256(WS_BIG + (size_t)MP * RIN * 2);
constexpr size_t WS_GGL = al256(WS_GAT + (size_t)2048 * 64 * 64 * 2);
constexpr size_t WS_END = al256(WS_GGL + (size_t)2048 * 4);
constexpr size_t WS_GWK = WS_YA;
constexpr size_t WS_GQG = WS_O + (size_t)MP * D * 2;
constexpr size_t WS_GKG = WS_BIG + (size_t)MP * 4096 * 2;
constexpr size_t WS_GU = WS_GKG + (size_t)2048 * 64 * 128 * 2;
static_assert((size_t)2048 * 64 * 128 * 2 <= (size_t)MP * D * 2, "gdn scratch");
static_assert(WS_GU + (size_t)2048 * 64 * 128 * 2 <= WS_BIG + (size_t)MP * RIN * 2, "gdn scratch");

struct Params { const float* in[20]; float* out; unsigned char* ws; int ph_lo, ph_hi; };
constexpr int PTAB_OFF = 144 * 1024 - 256;
struct Ctx {
    const unsigned __attribute__((address_space(3)))* tab;
    __device__ __forceinline__ unsigned long long raw(int i) const {
        const unsigned lo = __builtin_amdgcn_readfirstlane(tab[2 * i]), hi = __builtin_amdgcn_readfirstlane(tab[2 * i + 1]);
        return ((unsigned long long)hi << 32) | lo; }
    __device__ __forceinline__ const float* in(int i) const { return (const float*)raw(i); }
    __device__ __forceinline__ float* out() const { return (float*)raw(20); }
    __device__ __forceinline__ unsigned char* ws() const { return (unsigned char*)raw(21); }
};

__device__ __forceinline__ unsigned cvt_pk_bf16(float lo, float hi) { unsigned r; asm("v_cvt_pk_bf16_f32 %0, %1, %2" : "=v"(r) : "v"(lo), "v"(hi)); return r; }
__device__ __forceinline__ float bf_lo(unsigned w) { return __uint_as_float(w << 16); }
__device__ __forceinline__ float bf_hi(unsigned w) { return __uint_as_float(w & 0xffff0000u); }
__device__ __forceinline__ float bf2f(bf16_t b) { return __uint_as_float(((unsigned)b) << 16); }
__device__ __forceinline__ bf16_t f2bf(float f) { return (bf16_t)(cvt_pk_bf16(f, 0.f) & 0xffffu); }
__device__ __forceinline__ float fsigmoid(float x) { return __builtin_amdgcn_rcpf(1.0f + __expf(-x)); }
__device__ __forceinline__ float fsilu(float x) { return x * fsigmoid(x); }
__device__ __forceinline__ int opaque_tid() { int t = threadIdx.x; asm volatile("" : "+v"(t)); return t; }
__device__ __forceinline__ float wave_sum(float v) {
#pragma unroll
    for (int o = 32; o >= 1; o >>= 1) v += __shfl_xor(v, o);
    return v;
}
__device__ __forceinline__ void ln_finish(float s, float q, float& mu, float& rstd) {
    mu = s * (1.0f / 1024.0f);
    const float var = fmaxf(q * (1.0f / 1024.0f) - mu * mu, 0.f);
    rstd = rsqrtf(var + LN_EPS);
}
__device__ __forceinline__ void ln_stats(const float* st, int r, float& mu, float& rstd) {
    const f32x4* sp = (const f32x4*)(st + 32 * (size_t)r);
    float s = 0.f, q = 0.f;
#pragma unroll
    for (int i = 0; i < 8; ++i) { const f32x4 v = sp[i]; s += v.x; q += v.y; s += v.z; q += v.w; }
    ln_finish(s, q, mu, rstd);
}
__device__ __forceinline__ void ln_stats4(const float* st, int r, int fq, float& mu, float& rstd) {
    const f32x4* sp = (const f32x4*)(st + 32 * (size_t)r) + 2 * fq;
    const f32x4 v0 = sp[0], v1 = sp[1];
    float s = (v0.x + v0.z) + (v1.x + v1.z), q = (v0.y + v0.w) + (v1.y + v1.w);
    s += __shfl_xor(s, 16); q += __shfl_xor(q, 16); s += __shfl_xor(s, 32); q += __shfl_xor(q, 32);
    ln_finish(s, q, mu, rstd);
}

namespace pg8 {
constexpr int BM = 256, BK = 64, HALF = 128, HTB = HALF * BK * 2, STAGE_BYTES = 8 * HTB, NXCD = 8, WGM = 8;
__device__ __forceinline__ int lds_byte(int r, int c) { const int st = (r >> 4) * 2 + (c >> 5), rr = r & 15, cc = c & 31, ob = rr * 64 + cc * 2; return st * 1024 + (ob ^ (((ob >> 9) & 1) << 5)); }
__device__ __forceinline__ void stage_rc(int b, int& R, int& C) { const int st = b / 1024, sb = b % 1024, swz = sb ^ (((sb >> 9) & 1) << 5); R = (st >> 1) * 16 + swz / 64; C = (st & 1) * 32 + (swz % 64) / 2; }
__device__ __forceinline__ int perm32(int rho) { const int n = rho >> 4, i = rho & 15; return 8 * (i >> 2) + 4 * n + (i & 3); }

struct Unit { int pm, pn; };
struct Gemm { const bf16_t* A; const bf16_t* Bt; int lda, K, nM, nN, apn; };

struct StaticOrder {
    int nM, nN, nwg, G, c;
    __device__ void init(int nM_, int nN_, int G_, int c_) { nM = nM_; nN = nN_; nwg = nM * nN; G = G_; c = c_; }
    __device__ bool next(int i, Unit& u) const {
        const long L = (long)i * G + c; if (L >= nwg) return false;
        int wgid = (int)L; { const int q = nwg / NXCD, r = nwg % NXCD, xcd = wgid % NXCD, off = wgid / NXCD; wgid = (xcd < r ? xcd * (q + 1) : r * (q + 1) + (xcd - r) * q) + off; }
        const int nig = WGM * nN, gid = wgid / nig, fm = gid * WGM, gsz = (nM - fm) < WGM ? (nM - fm) : WGM;
        u.pm = fm + ((wgid % nig) % gsz); u.pn = (wgid % nig) / gsz; return true;
    }
};

template <class Epi>
__device__ __forceinline__ void gemm_phase(LAS unsigned char* lds, const Gemm g, const StaticOrder& S, const Epi& E) {
    int tid_ = threadIdx.x; asm volatile("" : "+v"(tid_));
    const int tid = tid_, wid = __builtin_amdgcn_readfirstlane(tid >> 6), lane = tid & 63, wr = wid >> 2, wc = wid & 3, fr = lane & 15, fq = lane >> 4;
    const int K = g.K, nt = K / BK;
    unsigned voffA[2], voffB[2];
#pragma unroll
    for (int i = 0; i < 2; ++i) { int R, C; stage_rc(tid * 16 + i * 8192, R, C); const int Rb = (R & ~31) + perm32(R & 31);
        voffA[i] = (unsigned)(R * g.lda + C) * 2u; voffB[i] = (unsigned)(Rb * K + C) * 2u; }
    const size_t kstep = (size_t)(BK * 2);
    const size_t hstepA = (size_t)HALF * g.lda * 2, hstepB = (size_t)HALF * K * 2;
    const size_t tstepA = 2 * hstepA, tstepB = 2 * hstepB;
    const unsigned ldsw = (unsigned)wid * 1024u;
    const int aoff = lds_byte(wr * 64 + fr, fq * 8), boff = lds_byte(wc * 32 + fr, fq * 8);
#define PG8_SA(b, h) (((b) * 2 + (h)) * HTB)
#define PG8_SB(b, h) ((4 + (b) * 2 + (h)) * HTB)
#define PG8_STAGE(bufoff, gbase, voff) do { _Pragma("unroll") for (int _i = 0; _i < 2; ++_i) \
        __builtin_amdgcn_global_load_lds((const unsigned*)((const char*)(gbase) + (voff)[_i]), (LAS unsigned*)(lds + (bufoff) + ldsw + _i * 8192), 16, 0, 0); } while (0)
#define PG8_LDA(dst, b, h) do { _Pragma("unroll") for (int m = 0; m < 4; ++m) _Pragma("unroll") for (int k = 0; k < 2; ++k) dst[m][k] = *(const LAS bf16x8*)(lds + PG8_SA(b, h) + aoff + m * 2048 + k * 1024); } while (0)
#define PG8_LDB(dst, b, h) do { _Pragma("unroll") for (int n = 0; n < 2; ++n) _Pragma("unroll") for (int k = 0; k < 2; ++k) dst[n][k] = *(const LAS bf16x8*)(lds + PG8_SB(b, h) + boff + n * 2048 + k * 1024); } while (0)
#define PG8_MMA(ai, bj, At, Bt) do { __builtin_amdgcn_s_setprio(1); _Pragma("unroll") for (int m = 0; m < 4; ++m) _Pragma("unroll") for (int n = 0; n < 2; ++n) _Pragma("unroll") for (int k = 0; k < 2; ++k) \
        acc[ai][bj][m][n] = __builtin_amdgcn_mfma_f32_16x16x32_bf16(Bt[n][k], At[m][k], acc[ai][bj][m][n], 0, 0, 0); __builtin_amdgcn_s_setprio(0); } while (0)
#define PG8_WAIT_V(n) asm volatile("s_waitcnt vmcnt(" #n ")" ::: "memory")
#define PG8_WAIT_L(n) asm volatile("s_waitcnt lgkmcnt(" #n ")" ::: "memory")
#define PG8_BAR __builtin_amdgcn_s_barrier()
#define PG8_SCHED __builtin_amdgcn_sched_barrier(0)
    Unit cur, nxt; int ui = 0;
    if (!S.next(0, cur)) return;
    f32x4 acc[2][2][4][2];
#pragma unroll
    for (int a = 0; a < 2; ++a)
#pragma unroll
        for (int b = 0; b < 2; ++b)
#pragma unroll
            for (int m = 0; m < 4; ++m)
#pragma unroll
                for (int n = 0; n < 2; ++n) acc[a][b][m][n] = (f32x4){0.f, 0.f, 0.f, 0.f};
    bf16x8 At[4][2], B0[2][2], B1[2][2];
    const char* cA = (const char*)g.A + (size_t)cur.pm * tstepA + (size_t)cur.pn * g.apn; const char* cB = (const char*)g.Bt + (size_t)cur.pn * tstepB;
    PG8_STAGE(PG8_SB(0, 0), cB, voffB); PG8_STAGE(PG8_SA(0, 0), cA, voffA); PG8_STAGE(PG8_SB(0, 1), cB + hstepB, voffB); PG8_STAGE(PG8_SA(0, 1), cA + hstepA, voffA);
    if (wr == 1) PG8_BAR;
    PG8_WAIT_V(4); PG8_BAR;
    PG8_STAGE(PG8_SB(1, 0), cB + kstep, voffB); PG8_STAGE(PG8_SA(1, 0), cA + kstep, voffA); PG8_STAGE(PG8_SB(1, 1), cB + hstepB + kstep, voffB);
    PG8_WAIT_V(6); PG8_BAR;
    for (;;) {
        const bool has_next = S.next(ui + 1, nxt);
        const char* nA = has_next ? (const char*)g.A + (size_t)nxt.pm * tstepA + (size_t)nxt.pn * g.apn : cA; const char* nB = has_next ? (const char*)g.Bt + (size_t)nxt.pn * tstepB : cB;
        for (int t = 0; t < nt; t += 2) {
            const bool last = (t == nt - 2);
            const char* a1 = cA + (size_t)(t + 1) * kstep;
            const char* a2 = last ? nA : cA + (size_t)(t + 2) * kstep; const char* b2 = last ? nB : cB + (size_t)(t + 2) * kstep;
            const char* a3 = a2 + kstep; const char* b3 = b2 + kstep;
            PG8_LDB(B0, 0, 0); PG8_SCHED; PG8_LDA(At, 0, 0); PG8_STAGE(PG8_SA(1, 1), a1 + hstepA, voffA);
            PG8_WAIT_L(8); PG8_BAR; PG8_WAIT_L(0); PG8_MMA(0, 0, At, B0); PG8_BAR; PG8_SCHED;
            PG8_LDB(B1, 0, 1); PG8_STAGE(PG8_SB(0, 0), b2, voffB);
            PG8_BAR; PG8_WAIT_L(0); PG8_MMA(0, 1, At, B1); PG8_BAR;
            PG8_LDA(At, 0, 1); PG8_STAGE(PG8_SA(0, 0), a2, voffA);
            PG8_BAR; PG8_WAIT_L(0); PG8_MMA(1, 0, At, B0); PG8_BAR; PG8_SCHED;
            PG8_STAGE(PG8_SB(0, 1), b2 + hstepB, voffB);
            PG8_WAIT_V(6); PG8_BAR; PG8_MMA(1, 1, At, B1); PG8_BAR;
            PG8_LDB(B0, 1, 0); PG8_SCHED; PG8_LDA(At, 1, 0); PG8_STAGE(PG8_SA(0, 1), a2 + hstepA, voffA);
            PG8_WAIT_L(8); PG8_BAR; PG8_WAIT_L(0); PG8_MMA(0, 0, At, B0); PG8_BAR; PG8_SCHED;
            PG8_LDB(B1, 1, 1); PG8_STAGE(PG8_SB(1, 0), b3, voffB);
            PG8_BAR; PG8_WAIT_L(0); PG8_MMA(0, 1, At, B1); PG8_BAR;
            PG8_LDA(At, 1, 1); PG8_STAGE(PG8_SA(1, 0), a3, voffA);
            PG8_BAR; PG8_WAIT_L(0); PG8_MMA(1, 0, At, B0); PG8_BAR; PG8_SCHED;
            PG8_STAGE(PG8_SB(1, 1), b3 + hstepB, voffB);
            PG8_WAIT_V(6); PG8_BAR; PG8_MMA(1, 1, At, B1); PG8_BAR;
        }
        E(acc, cur, wr, wc, fr, fq);
        if (!has_next) break;
#pragma unroll
        for (int a = 0; a < 2; ++a)
#pragma unroll
            for (int b = 0; b < 2; ++b)
#pragma unroll
                for (int m = 0; m < 4; ++m)
#pragma unroll
                    for (int n = 0; n < 2; ++n) acc[a][b][m][n] = (f32x4){0.f, 0.f, 0.f, 0.f};
        cur = nxt; cA = nA; cB = nB; ++ui;
    }
    PG8_WAIT_V(0);
    if (wr == 0) PG8_BAR;
    PG8_BAR;
#undef PG8_SA
#undef PG8_SB
#undef PG8_STAGE
#undef PG8_LDA
#undef PG8_LDB
#undef PG8_MMA
#undef PG8_WAIT_V
#undef PG8_WAIT_L
#undef PG8_BAR
#undef PG8_SCHED
}
}

enum { E_RES_IN = 0, E_RES_LN = 1, E_SWIGLU = 2, E_GDN = 3, E_RET = 4 };
template <int MODE> struct Epi {
    const float* st_in; const float* c1; const float* c2;
    const float* xp; const float* xs;
    const bf16_t* yprev; const float* lg; const float* lb;
    const float* cscale;
    float* st_out; bf16_t* yout;
    bf16_t* ob; float* of; const float* rope;
    __device__ __forceinline__ void operator()(const f32x4 (&acc)[2][2][4][2], const pg8::Unit& u, int wr, int wc, int fr, int fq) const {
        const int rowb = u.pm * 256 + wr * 64 + fr;
        const int colb = u.pn * 256 + wc * 32 + 8 * fq;
#pragma unroll
        for (int ai = 0; ai < 2; ++ai)
#pragma unroll
            for (int m = 0; m < 4; ++m) {
                const int r = rowb + ai * 128 + m * 16;
                float mu = 0.f, rstd = 1.f;
                if constexpr (MODE != E_RES_IN) ln_stats4(st_in, r, fq, mu, rstd);
                if constexpr (MODE < 2) {
                    float s = 0.f, q = 0.f;
#pragma unroll
                    for (int bj = 0; bj < 2; ++bj) {
                        const int c0 = colb + bj * 128;
                        f32x4 x0, x1;
                        if constexpr (MODE == E_RES_IN) {
                            const float* src = (u.pm < MPR / 256 ? xp + (size_t)r * D : xs + (size_t)(r - MPR < NS ? r - MPR : NS - 1) * D);
                            x0 = *(const f32x4*)(src + c0); x1 = *(const f32x4*)(src + c0 + 4);
                        } else {
                            const u32x4 w = *(const u32x4*)(yprev + (size_t)r * D + c0);
                            x0 = (f32x4){bf_lo(w.x), bf_hi(w.x), bf_lo(w.y), bf_hi(w.y)}; x1 = (f32x4){bf_lo(w.z), bf_hi(w.z), bf_lo(w.w), bf_hi(w.w)};
                            x0 = (x0 - mu) * rstd * *(const f32x4*)(lg + c0) + *(const f32x4*)(lb + c0); x1 = (x1 - mu) * rstd * *(const f32x4*)(lg + c0 + 4) + *(const f32x4*)(lb + c0 + 4);
                        }
                        f32x4 a0 = acc[ai][bj][m][0], a1 = acc[ai][bj][m][1];
                        if (cscale) { a0 *= *(const f32x4*)(cscale + c0); a1 *= *(const f32x4*)(cscale + c0 + 4); }
                        const f32x4 y0 = x0 * DN_ALPHA + a0, y1 = x1 * DN_ALPHA + a1;
                        u32x4 o; o.x = cvt_pk_bf16(y0[0], y0[1]); o.y = cvt_pk_bf16(y0[2], y0[3]); o.z = cvt_pk_bf16(y1[0], y1[1]); o.w = cvt_pk_bf16(y1[2], y1[3]);
                        *(u32x4*)(yout + (size_t)r * D + c0) = o;
                        s += (y0[0] + y0[1]) + (y0[2] + y0[3]) + (y1[0] + y1[1]) + (y1[2] + y1[3]);
                        q += (y0[0] * y0[0] + y0[1] * y0[1]) + (y0[2] * y0[2] + y0[3] * y0[3]) + (y1[0] * y1[0] + y1[1] * y1[1]) + (y1[2] * y1[2] + y1[3] * y1[3]);
                    }
                    s += __shfl_xor(s, 16); s += __shfl_xor(s, 32); q += __shfl_xor(q, 16); q += __shfl_xor(q, 32);
                    if (fq == 0) *(f32x2*)(st_out + 32 * (size_t)r + 2 * (u.pn * 4 + wc)) = (f32x2){s, q};
                } else {
#pragma unroll
                    for (int bj = 0; bj < 2; ++bj) {
                        const int c0 = colb + bj * 128;
                        const f32x4 h0 = (acc[ai][bj][m][0] - *(const f32x4*)(c1 + c0) * mu) * rstd + *(const f32x4*)(c2 + c0), h1 = (acc[ai][bj][m][1] - *(const f32x4*)(c1 + c0 + 4) * mu) * rstd + *(const f32x4*)(c2 + c0 + 4);
                        if constexpr (MODE == E_SWIGLU) {
                            u32x2 o; o.x = cvt_pk_bf16(fsilu(h0[0]) * h0[1], fsilu(h0[2]) * h0[3]); o.y = cvt_pk_bf16(fsilu(h1[0]) * h1[1], fsilu(h1[2]) * h1[3]);
                            *(u32x2*)(ob + (size_t)r * DFF + (c0 >> 1)) = o;
                        } else if constexpr (MODE == E_GDN) {
                            if (c0 < 4096) {
                                u32x4 o; o.x = cvt_pk_bf16(h0[0], h0[1]); o.y = cvt_pk_bf16(h0[2], h0[3]); o.z = cvt_pk_bf16(h1[0], h1[1]); o.w = cvt_pk_bf16(h1[2], h1[3]);
                                *(u32x4*)(ob + (size_t)r * 4096 + c0) = o;
                            } else if (c0 < GIN) {
                                *(f32x4*)(of + (size_t)r * 16 + (c0 - 4096)) = h0; *(f32x4*)(of + (size_t)r * 16 + (c0 - 4096) + 4) = h1;
                            }
                        } else {
                            if (u.pn < 8) {
                                const int pidx = r < MPR ? (r & (T - 1)) : T;
                                const int hb = c0 & ~127, i0 = (c0 & 127) >> 1;
                                const f32x4 t0 = *(const f32x4*)(rope + ((size_t)pidx * 64 + i0) * 2), t1 = *(const f32x4*)(rope + ((size_t)pidx * 64 + i0) * 2 + 4);
                                const float sc = c0 >= 1024 ? 0.088388347648318f : 1.0f;
                                const float a0 = (h0[0] * t0[0] - h0[1] * t0[1]) * sc, a1 = (h0[2] * t0[2] - h0[3] * t0[3]) * sc, a2 = (h1[0] * t1[0] - h1[1] * t1[1]) * sc, a3 = (h1[2] * t1[2] - h1[3] * t1[3]) * sc;
                                const float e0 = (h0[0] * t0[1] + h0[1] * t0[0]) * sc, e1 = (h0[2] * t0[3] + h0[3] * t0[2]) * sc, e2 = (h1[0] * t1[1] + h1[1] * t1[0]) * sc, e3 = (h1[2] * t1[3] + h1[3] * t1[2]) * sc;
                                u32x2 o1, o2; o1.x = cvt_pk_bf16(a0, a1); o1.y = cvt_pk_bf16(a2, a3); o2.x = cvt_pk_bf16(e0, e1); o2.y = cvt_pk_bf16(e2, e3);
                                *(u32x2*)(ob + (size_t)r * RIN + hb + i0) = o1; *(u32x2*)(ob + (size_t)r * RIN + hb + 64 + i0) = o2;
                            } else {
                                u32x4 o; o.x = cvt_pk_bf16(h0[0], h0[1]); o.y = cvt_pk_bf16(h0[2], h0[3]); o.z = cvt_pk_bf16(h1[0], h1[1]); o.w = cvt_pk_bf16(h1[2], h1[3]);
                                *(u32x4*)(ob + (size_t)r * RIN + c0) = o;
                            }
                        }
                    }
                }
                asm volatile("" ::: "memory");
            }
    }
};

template <int MAP  >
__device__ __forceinline__ int map_col(int j) {
    if (MAP == 1) return 2 * (j % DFF) + (j / DFF);
    if (MAP == 2) { if (j < 2048) { const int hb = j & ~127, d = j & 127; return hb + 2 * (d & 63) + (d >> 6); } }
    return j;
}
template <int MAP>
__device__ __forceinline__ void transpose_tile(int tid, LAS float* tile, const float* __restrict__ src, int Nsrc, int K, int k0, int j0, bf16_t* __restrict__ dst,
                                               const float* __restrict__ g, const float* __restrict__ b, float& s1, float& s2) {
#pragma unroll
    for (int p = 0; p < 2; ++p) {
        const int idx = tid + p * 512, kk = idx >> 4, j4 = (idx & 15) * 4;
        f32x4 v = (f32x4){0.f, 0.f, 0.f, 0.f};
        if (j0 + j4 < Nsrc) v = *(const f32x4*)(src + (size_t)(k0 + kk) * Nsrc + j0 + j4);
        tile[kk * 65 + j4 + 0] = v[0]; tile[kk * 65 + j4 + 1] = v[1]; tile[kk * 65 + j4 + 2] = v[2]; tile[kk * 65 + j4 + 3] = v[3];
    }
    __syncthreads();
    const int jj = tid >> 3, kc = tid & 7, j = j0 + jj;
    const int n = map_col<MAP>(j);
    unsigned w[4];
#pragma unroll
    for (int e = 0; e < 4; ++e) {
        const int ka = kc * 8 + 2 * e;
        const float v0 = tile[ka * 65 + jj], v1 = tile[(ka + 1) * 65 + jj];
        float g0 = 1.f, g1 = 1.f;
        if (g) { g0 = g[k0 + ka]; g1 = g[k0 + ka + 1]; }
        w[e] = cvt_pk_bf16(v0 * g0, v1 * g1);
        if (g) { s1 += bf_lo(w[e]) + bf_hi(w[e]); s2 += b[k0 + ka] * v0 + b[k0 + ka + 1] * v1; }
    }
    if (j < Nsrc) { u32x4 o; o.x = w[0]; o.y = w[1]; o.z = w[2]; o.w = w[3]; *(u32x4*)(dst + (size_t)n * K + k0 + kc * 8) = o; }
    __syncthreads();
}
template <int MAP>
__device__ __forceinline__ void fold_strip(int tid, LAS float* tile, const float* __restrict__ src, int Nsrc, int j0, bf16_t* __restrict__ dst,
                                           const float* __restrict__ g, const float* __restrict__ b, float* c1, float* c2) {
    float s1 = 0.f, s2 = 0.f;
    for (int kt = 0; kt < 16; ++kt) transpose_tile<MAP>(tid, tile, src, Nsrc, 1024, kt * 64, j0, dst, g, b, s1, s2);
    s1 += __shfl_xor(s1, 1); s1 += __shfl_xor(s1, 2); s1 += __shfl_xor(s1, 4);
    s2 += __shfl_xor(s2, 1); s2 += __shfl_xor(s2, 2); s2 += __shfl_xor(s2, 4);
    const int j = j0 + (tid >> 3);
    if ((tid & 7) == 0 && j < Nsrc) { const int n = map_col<MAP>(j); c1[n] = s1; c2[n] = s2; }
}

template <int LAYER>
__device__ __forceinline__ f32x2 pool_x(const float* xin, const bf16_t* y, const float* st, const f32x2 g2, const f32x2 b2, int r, int c) {
    if constexpr (LAYER == 0) { return *(const f32x2*)(xin + (size_t)r * D + c); }
    else { float mu, rstd; ln_stats(st, r, mu, rstd); const unsigned w = *(const unsigned*)(y + (size_t)r * D + c); f32x2 v; v.x = (bf_lo(w) - mu) * rstd * g2.x + b2.x; v.y = (bf_hi(w) - mu) * rstd * g2.y + b2.y; return v; }
}
template <int LAYER>
__device__ void pool_stencil_phase(const Ctx& p, int li  , const bf16_t* y, const float* st, const float* lg, const float* lb, bf16_t* apool) {
    const int tid = opaque_tid(), c = tid * 2;
    const int win = 2 << (c >> 8);
    f32x2 g2 = (f32x2){1.f, 1.f}, b2 = (f32x2){0.f, 0.f};
    if constexpr (LAYER != 0) { g2 = *(const f32x2*)(lg + c); b2 = *(const f32x2*)(lb + c); }
    const float* xp = p.in(0);
    float* out = p.out();
    for (int item = blockIdx.x; item < NB * 64; item += gridDim.x) {
        const int b = item >> 6, t0 = (item & 63) * 32, rb = b * T;
        f32x2 s = (f32x2){0.f, 0.f};
        for (int j = 1; j < win; ++j) if (t0 - j >= 0) { const f32x2 v = pool_x<LAYER>(xp, y, st, g2, b2, rb + t0 - j, c); s += v; }
        for (int t = t0; t < t0 + 32; ++t) {
            const f32x2 xv = pool_x<LAYER>(xp, y, st, g2, b2, rb + t, c);
            s += xv;
            const float inv = 1.0f / (float)(t + 1 < win ? t + 1 : win);
            const f32x2 pv = s * inv - xv;
            *(unsigned*)(apool + (size_t)(rb + t) * D + c) = cvt_pk_bf16(pv.x, pv.y);
            if (t >= T - PBUF) *(f32x2*)(out + O_PP + ((size_t)(li * NB + b) * PBUF + (t - (T - PBUF))) * D + c) = xv;
            if (t - win + 1 >= 0) { const f32x2 v = pool_x<LAYER>(xp, y, st, g2, b2, rb + t - win + 1, c); s -= v; }
        }
    }
    const float* spool = p.in(2) + (size_t)li * NS * PBUF * D;
    for (int i = blockIdx.x; i < NS; i += gridDim.x) {
        f32x2 xv;
        if constexpr (LAYER == 0) xv = *(const f32x2*)(p.in(1) + (size_t)i * D + c); else xv = pool_x<LAYER>(nullptr, y, st, g2, b2, MPR + i, c);
        f32x2 s = xv;
        for (int j = 1; j < win; ++j) s += *(const f32x2*)(spool + ((size_t)i * PBUF + (PBUF - j)) * D + c);
        const f32x2 pv = s * (1.0f / (float)win) - xv;
        *(unsigned*)(apool + (size_t)(MPR + i) * D + c) = cvt_pk_bf16(pv.x, pv.y);
        float* dst = out + O_PS + ((size_t)(li * NS + i) * PBUF) * D + c;
        for (int q = 0; q < PBUF - 1; ++q) *(f32x2*)(dst + (size_t)q * D) = *(const f32x2*)(spool + ((size_t)i * PBUF + q + 1) * D + c);
        *(f32x2*)(dst + (size_t)(PBUF - 1) * D) = xv;
    }
}

__device__ void prep_phase(const Ctx& p, LAS unsigned char* lds) {
    LAS float* tile = (LAS float*)lds;
    unsigned char* ws = p.ws();
    const int G = gridDim.x, bid = blockIdx.x, tid = opaque_tid();
    float* c1 = (float*)(ws + WS_C1); float* c2 = (float*)(ws + WS_C2);
    const float* ln_g = p.in(18); const float* ln_b = p.in(19);
    float d1 = 0.f, d2 = 0.f;
    for (int t = bid; t < 4 * 88 + 65 + 96; t += G) {
        if (t < 352) { const int mi = t / 88, jt = t % 88;
            fold_strip<1>(tid, tile, p.in(16) + (size_t)mi * 1024 * 5632, 5632, jt * 64, (bf16_t*)(ws + WS_W13) + (size_t)mi * 5632 * 1024, ln_g + (size_t)(mi * 2) * D, ln_b + (size_t)(mi * 2) * D, c1 + mi * 5632, c2 + mi * 5632); }
        else if (t < 352 + 65) { fold_strip<0>(tid, tile, p.in(8), GIN, (t - 352) * 64, (bf16_t*)(ws + WS_WGI), ln_g + 1 * D, ln_b + 1 * D, c1 + 4 * 5632, c2 + 4 * 5632); }
        else { fold_strip<2>(tid, tile, p.in(14), RIN, (t - 417) * 64, (bf16_t*)(ws + WS_WRI), ln_g + 3 * D, ln_b + 3 * D, c1 + 4 * 5632 + GINP, c2 + 4 * 5632 + GINP); }
    }
    for (int t = bid; t < 8 * 16; t += G) { const int mi = t >> 4, tt = t & 15;
        transpose_tile<0>(tid, tile, p.in(6) + (size_t)mi * 65536, 256, 256, (tt >> 2) * 64, (tt & 3) * 64, (bf16_t*)(ws + WS_WPOOL) + (size_t)mi * 65536, nullptr, nullptr, d1, d2); }
    for (int t = bid; t < 4 * 44 * 16; t += G) { const int mi = t / 704, tt = t % 704, kt = tt / 16, jt = tt % 16;
        transpose_tile<0>(tid, tile, p.in(17) + (size_t)mi * 2816 * 1024, 1024, 2816, kt * 64, jt * 64, (bf16_t*)(ws + WS_W2) + (size_t)mi * 1024 * 2816, nullptr, nullptr, d1, d2); }
    for (int t = bid; t < 16 * 16; t += G) { const int kt = t / 16, jt = t % 16;
        transpose_tile<0>(tid, tile, p.in(13), 1024, 1024, kt * 64, jt * 64, (bf16_t*)(ws + WS_WGO), nullptr, nullptr, d1, d2); }
    for (int t = bid; t < 32 * 16; t += G) { const int kt = t / 16, jt = t % 16;
        transpose_tile<0>(tid, tile, p.in(15), 1024, 2048, kt * 64, jt * 64, (bf16_t*)(ws + WS_WRO), nullptr, nullptr, d1, d2); }
    for (size_t i = (size_t)bid * 512 + tid; i < (size_t)(GINP - GIN) * 1024 / 8; i += (size_t)G * 512) ((u32x4*)((bf16_t*)(ws + WS_WGI) + (size_t)GIN * 1024))[i] = (u32x4){0u, 0u, 0u, 0u};
    float* rope = (float*)(ws + WS_ROPE);
    for (int e = bid * 512 + tid; e < 2049 * 64; e += G * 512) {
        const int i = e & 63, pi = e >> 6; const double pos = pi < T ? (double)pi : 16384.0;
        const double freq = exp(-(double)i * (9.210340371976184 / 64.0));
        const double rev = pos * freq * 0.15915494309189535; const float fr = (float)(rev - floor(rev));
        rope[2 * e] = __builtin_amdgcn_cosf(fr); rope[2 * e + 1] = __builtin_amdgcn_sinf(fr);
    }
    pool_stencil_phase<0>(p, 0, nullptr, nullptr, nullptr, nullptr, (bf16_t*)(ws + WS_O));
}

typedef short s16x4 __attribute__((ext_vector_type(4)));
typedef __bf16 bf16v2 __attribute__((ext_vector_type(2)));
__device__ __forceinline__ unsigned pkbf(float lo, float hi) { bf16v2 v = {(__bf16)lo, (__bf16)hi}; return __builtin_bit_cast(unsigned, v); }
#define MFMA16(a, b, c) __builtin_amdgcn_mfma_f32_16x16x32_bf16((a), (b), (c), 0, 0, 0)
__device__ __forceinline__ bf16x8 tr_frag(LAS const unsigned char* img, int pitch, int k0, int c0, int lane) {
    const int i16 = lane & 15;
    LAS const unsigned char* a = img + (k0 + 8 * (lane >> 4) + (i16 >> 2)) * pitch + (c0 + 4 * (i16 & 3)) * 2;
    const s16x4 lo = __builtin_amdgcn_ds_read_tr16_b64_v4i16((LAS s16x4*)a);
    const s16x4 hi = __builtin_amdgcn_ds_read_tr16_b64_v4i16((LAS s16x4*)(a + 4 * pitch));
    return __builtin_shufflevector(lo, hi, 0, 1, 2, 3, 4, 5, 6, 7);
}
__device__ __forceinline__ bf16x8 row_frag(LAS const unsigned char* img, int pitch, int r0, int k0, int lane) {
    return *(LAS const bf16x8*)(img + (r0 + (lane & 15)) * pitch + (k0 + 8 * (lane >> 4)) * 2);
}
__device__ __forceinline__ bf16x8 row_frag_perm(LAS const unsigned char* img, int pitch, int r0, int k0, int lane) {
    LAS const unsigned char* a = img + (r0 + (lane & 15)) * pitch + (k0 + 4 * (lane >> 4)) * 2;
    const s16x4 lo = *(LAS const s16x4*)a, hi = *(LAS const s16x4*)(a + 32);
    return __builtin_shufflevector(lo, hi, 0, 1, 2, 3, 4, 5, 6, 7);
}
__device__ __forceinline__ bf16x8 pack_acc_pair(const f32x4& x, const f32x4& y) {
    u32x4 w; w.x = pkbf(x[0], x[1]); w.y = pkbf(x[2], x[3]); w.z = pkbf(y[0], y[1]); w.w = pkbf(y[2], y[3]);
    return __builtin_bit_cast(bf16x8, w);
}


__device__ void gdn_phase_a(const Ctx& p, LAS unsigned char* lds) {
    constexpr int PQ = 272, PX = 144, LP = 68;
    unsigned char* ws = p.ws();
    const bf16_t* PROJ = (const bf16_t*)(ws + WS_BIG); const float* PROJS = (const float*)(ws + WS_PROJS);
    bf16_t* GWK = (bf16_t*)(ws + WS_GWK); bf16_t* GQG = (bf16_t*)(ws + WS_GQG); bf16_t* GKG = (bf16_t*)(ws + WS_GKG); bf16_t* GU = (bf16_t*)(ws + WS_GU);
    bf16_t* GAT = (bf16_t*)(ws + WS_GAT); float* GGL = (float*)(ws + WS_GGL);
    LAS unsigned char* Kr = lds; LAS unsigned char* Qr = Kr + 64 * PQ; LAS unsigned char* VB = Qr + 64 * PQ; LAS unsigned char* KE = VB + 64 * PQ;
    LAS float* Lf = (LAS float*)(KE + 64 * PQ); LAS unsigned char* Xr = (LAS unsigned char*)(Lf + 64 * LP);
    LAS float* cw = (LAS float*)(Xr + 64 * PX); LAS float* gcs = cw + 4 * 384; LAS float* bet = gcs + 64;
    const int tid = opaque_tid(), lane = tid & 63, wid = __builtin_amdgcn_readfirstlane(tid >> 6), kg = lane >> 4, l15 = lane & 15;
    const int lrow = tid >> 3, lseg = tid & 7;
    const float* convw = p.in(9);
    for (int grp = blockIdx.x; grp < 256; grp += gridDim.x) {
        const int bh = grp >> 2, b = bh >> 3, h = bh & 7;
        __syncthreads();
        for (int i = tid; i < 4 * 384; i += 512) { const int j = i / 384, ch = i - j * 384; cw[i] = convw[j * CCH + (ch >> 7) * 1024 + h * 128 + (ch & 127)]; }
        const float Aneg = -__expf(p.in(10)[h]), dtb = p.in(11)[h];
        for (int e = 0; e < 8; ++e) {
            const int n = (grp & 3) * 8 + e, item = bh * 32 + n, row0 = b * T + n * 64, tseq = n * 64 + lrow;
            float xv[3][16];
            __syncthreads();
#pragma unroll
            for (int part = 0; part < 3; ++part)
#pragma unroll
                for (int gs = 0; gs < 2; ++gs) {
                    const int ch0 = lseg * 16 + gs * 8, gcol = part * 1024 + h * 128 + ch0;
                    float a[8];
#pragma unroll
                    for (int q = 0; q < 8; ++q) a[q] = 0.f;
#pragma unroll
                    for (int j = 0; j < 4; ++j) {
                        if (tseq - 3 + j >= 0) {
                            const u32x4 x = *(const u32x4*)(PROJ + (size_t)(row0 + lrow - 3 + j) * 4096 + gcol);
                            const f32x4 w0 = *(LAS const f32x4*)(cw + j * 384 + part * 128 + ch0), w1 = *(LAS const f32x4*)(cw + j * 384 + part * 128 + ch0 + 4);
                            a[0] += w0[0] * bf_lo(x.x); a[1] += w0[1] * bf_hi(x.x); a[2] += w0[2] * bf_lo(x.y); a[3] += w0[3] * bf_hi(x.y);
                            a[4] += w1[0] * bf_lo(x.z); a[5] += w1[1] * bf_hi(x.z); a[6] += w1[2] * bf_lo(x.w); a[7] += w1[3] * bf_hi(x.w);
                        }
                    }
#pragma unroll
                    for (int q = 0; q < 8; ++q) xv[part][gs * 8 + q] = fsilu(a[q]);
                }
            float sq = 0.f, sk = 0.f;
#pragma unroll
            for (int q = 0; q < 16; ++q) { sq += xv[0][q] * xv[0][q]; sk += xv[1][q] * xv[1][q]; }
            sq += __shfl_xor(sq, 1); sq += __shfl_xor(sq, 2); sq += __shfl_xor(sq, 4); sk += __shfl_xor(sk, 1); sk += __shfl_xor(sk, 2); sk += __shfl_xor(sk, 4);
            const float qn = rsqrtf(sq + RMS_EPS) * 0.088388347648318f, kn = rsqrtf(sk + RMS_EPS);
            if (wid == 0) {
                const size_t r2 = (size_t)(row0 + lane);
                const float x = PROJS[r2 * 16 + 8 + h] + dtb; const float sp = x > 20.f ? x : log1pf(__expf(x));
                float g = Aneg * sp;
#pragma unroll
                for (int o = 1; o < 64; o <<= 1) { const float t = __shfl_up(g, o); if (lane >= o) g += t; }
                gcs[lane] = g; bet[lane] = fsigmoid(PROJS[r2 * 16 + h]);
            }
            __syncthreads();
            {
                const float gcr = gcs[lrow], gcl = gcs[63], br = bet[lrow];
                const float eg = __expf(gcr), egl = __expf(gcl - gcr);
                if (tid == 0) GGL[item] = __expf(gcl);
#pragma unroll
                for (int gs = 0; gs < 2; ++gs) {
                    u32x4 wq, wk_, wv, we, wqg, wkg;
                    unsigned* pq = (unsigned*)&wq; unsigned* pk = (unsigned*)&wk_; unsigned* pv = (unsigned*)&wv; unsigned* pe = (unsigned*)&we; unsigned* pqg = (unsigned*)&wqg; unsigned* pkg = (unsigned*)&wkg;
#pragma unroll
                    for (int q2 = 0; q2 < 4; ++q2) {
                        const float q0 = xv[0][gs * 8 + 2 * q2] * qn, q1 = xv[0][gs * 8 + 2 * q2 + 1] * qn, k0 = xv[1][gs * 8 + 2 * q2] * kn, k1 = xv[1][gs * 8 + 2 * q2 + 1] * kn;
                        const float v0 = xv[2][gs * 8 + 2 * q2], v1 = xv[2][gs * 8 + 2 * q2 + 1];
                        pq[q2] = pkbf(q0, q1); pk[q2] = pkbf(k0, k1); pv[q2] = pkbf(v0 * br, v1 * br); pe[q2] = pkbf(k0 * br * eg, k1 * br * eg);
                        pqg[q2] = pkbf(q0 * eg, q1 * eg); pkg[q2] = pkbf(k0 * egl, k1 * egl);
                    }
                    const int off = lrow * PQ + (lseg * 16 + gs * 8) * 2;
                    *(LAS u32x4*)(Qr + off) = wq; *(LAS u32x4*)(Kr + off) = wk_; *(LAS u32x4*)(VB + off) = wv; *(LAS u32x4*)(KE + off) = we;
                    const size_t go = ((size_t)item * 64 + lrow) * 128 + lseg * 16 + gs * 8;
                    *(u32x4*)(GQG + go) = wqg; *(u32x4*)(GKG + go) = wkg;
                }
            }
            __syncthreads();
            for (int u = wid; u < 16; u += 8) {
                const int it = u >> 2, jt = u & 3, i = it * 16 + l15, j0 = jt * 16 + 4 * kg;
                u32x2 ao = (u32x2){0u, 0u};
                if (jt <= it) {
                    f32x4 kk = (f32x4){0.f, 0.f, 0.f, 0.f}, qk = kk;
#pragma unroll
                    for (int ks = 0; ks < 4; ++ks) { const bf16x8 a = row_frag(Kr, PQ, jt * 16, ks * 32, lane);
                        kk = MFMA16(a, row_frag(Kr, PQ, it * 16, ks * 32, lane), kk); qk = MFMA16(a, row_frag(Qr, PQ, it * 16, ks * 32, lane), qk); }
                    const float gi = gcs[i], bi = bet[i];
                    float lv[4], av[4];
#pragma unroll
                    for (int r = 0; r < 4; ++r) { const int j = j0 + r; const float dec = i >= j ? __expf(gi - gcs[j]) : 0.f; lv[r] = i > j ? bi * kk[r] * dec : 0.f; av[r] = qk[r] * dec; }
                    *(LAS f32x4*)(Lf + i * LP + j0) = (f32x4){lv[0], lv[1], lv[2], lv[3]};
                    ao.x = pkbf(av[0], av[1]); ao.y = pkbf(av[2], av[3]);
                }
                *(u32x2*)(GAT + ((size_t)item * 64 + i) * 64 + j0) = ao;
            }
            __syncthreads();
            if (wid == 0) {
                float x[64];
                int ln = lane; asm volatile("" : "+v"(ln));
                LAS const float* Lb = Lf; asm volatile("" : "+v"(Lb));
                LAS unsigned char* Xb = Xr + ln * 2; asm volatile("" : "+v"(Xb));
#pragma unroll
                for (int i = 0; i < 64; ++i) x[i] = 0.f;
#pragma unroll
                for (int i = 0; i < 64; ++i) {
                    float a0 = ln == i ? 1.f : 0.f, a1 = 0.f;
#pragma unroll
                    for (int j4 = 0; j4 < (i + 3) / 4; ++j4) { const f32x4 l = *(LAS const f32x4*)(Lb + i * LP + 4 * j4);
                        a0 -= l[0] * x[4 * j4]; a1 -= l[1] * x[4 * j4 + 1]; a0 -= l[2] * x[4 * j4 + 2]; a1 -= l[3] * x[4 * j4 + 3]; }
                    x[i] = a0 + a1;
                    *(LAS bf16_t*)(Xb + i * PX) = (bf16_t)(pkbf(x[i], 0.f) & 0xffffu);
                }
            }
            __syncthreads();
            for (int t8 = 0; t8 < 8; ++t8) {
                const int tile = wid + 8 * t8, kind = tile >> 5, ct = (tile >> 2) & 7, it = tile & 3;
                f32x4 acc = (f32x4){0.f, 0.f, 0.f, 0.f};
#pragma unroll
                for (int ks = 0; ks < 2; ++ks) acc = MFMA16(tr_frag(kind ? KE : VB, PQ, ks * 32, ct * 16, lane), row_frag(Xr, PX, it * 16, ks * 32, lane), acc);
                u32x2 o; o.x = pkbf(acc[0], acc[1]); o.y = pkbf(acc[2], acc[3]);
                *(u32x2*)((kind ? GWK : GU) + ((size_t)item * 64 + it * 16 + l15) * 128 + ct * 16 + 4 * kg) = o;
            }
        }
    }
}

__device__ void gdn_phase_b(const Ctx& p, LAS unsigned char* lds) {
    constexpr int PQ = 272, PA = 144;
    unsigned char* ws = p.ws();
    const bf16_t* PROJ = (const bf16_t*)(ws + WS_BIG); const float* PROJS = (const float*)(ws + WS_PROJS); bf16_t* O = (bf16_t*)(ws + WS_O);
    const int tid = opaque_tid(), lane = tid & 63, wid = __builtin_amdgcn_readfirstlane(tid >> 6), kg = lane >> 4, l15 = lane & 15;
    const int G = gridDim.x, bid = blockIdx.x;
    const float* norm_g = p.in(12);
    const int n_prompt = (G > 64) ? 64 : 0;
    if (bid < n_prompt) {
        const bf16_t* GWK = (const bf16_t*)(ws + WS_GWK); const bf16_t* GQG = (const bf16_t*)(ws + WS_GQG); const bf16_t* GKG = (const bf16_t*)(ws + WS_GKG); const bf16_t* GU = (const bf16_t*)(ws + WS_GU);
        const bf16_t* GAT = (const bf16_t*)(ws + WS_GAT); const float* GGL = (const float*)(ws + WS_GGL);
        LAS unsigned char* Wk = lds; LAS unsigned char* Qg = Wk + 64 * PQ; LAS unsigned char* Kg = Qg + 64 * PQ; LAS unsigned char* Vn = Kg + 64 * PQ; LAS unsigned char* At = Vn + 64 * PQ;
        LAS float* part = (LAS float*)(At + 64 * PA);
        const int b = bid >> 3, h = bid & 7, lrow = tid >> 3, lseg = tid & 7;
        f32x4 S[8];
#pragma unroll
        for (int dt = 0; dt < 8; ++dt) S[dt] = (f32x4){0.f, 0.f, 0.f, 0.f};
        const f32x4 ng = *(const f32x4*)(norm_g + wid * 16 + 4 * kg);
        u32x4 rw[2], rqg[2], rkg[2], rat; u32x2 ru[4], rz[4]; float gl;
#define GDN_LOAD(n) do { const size_t it_ = (size_t)(bid * 32 + (n)); const size_t go_ = (it_ * 64 + lrow) * 128 + lseg * 16; \
            rw[0] = *(const u32x4*)(GWK + go_); rw[1] = *(const u32x4*)(GWK + go_ + 8); rqg[0] = *(const u32x4*)(GQG + go_); rqg[1] = *(const u32x4*)(GQG + go_ + 8); \
            rkg[0] = *(const u32x4*)(GKG + go_); rkg[1] = *(const u32x4*)(GKG + go_ + 8); rat = *(const u32x4*)(GAT + (it_ * 64 + lrow) * 64 + lseg * 8); gl = GGL[it_]; \
            _Pragma("unroll") for (int it2 = 0; it2 < 4; ++it2) { ru[it2] = *(const u32x2*)(GU + (it_ * 64 + it2 * 16 + l15) * 128 + wid * 16 + 4 * kg); \
                rz[it2] = *(const u32x2*)(PROJ + (size_t)(b * T + (n) * 64 + it2 * 16 + l15) * 4096 + 3072 + h * 128 + wid * 16 + 4 * kg); } } while (0)
        GDN_LOAD(0);
        for (int n = 0; n < T / 64; ++n) {
            __syncthreads();
#pragma unroll
            for (int e = 0; e < 2; ++e) { const int off = lrow * PQ + (lseg * 16 + e * 8) * 2; *(LAS u32x4*)(Wk + off) = rw[e]; *(LAS u32x4*)(Qg + off) = rqg[e]; *(LAS u32x4*)(Kg + off) = rkg[e]; }
            *(LAS u32x4*)(At + lrow * PA + lseg * 16) = rat;
            u32x2 cu[4], cz[4]; const float cgl = gl;
#pragma unroll
            for (int it = 0; it < 4; ++it) { cu[it] = ru[it]; cz[it] = rz[it]; }
            __syncthreads();
            if (n + 1 < T / 64) GDN_LOAD(n + 1);
            bf16x8 sp[4];
#pragma unroll
            for (int s4 = 0; s4 < 4; ++s4) sp[s4] = pack_acc_pair(S[2 * s4], S[2 * s4 + 1]);
#pragma unroll
            for (int it = 0; it < 4; ++it) {
                f32x4 pacc = (f32x4){0.f, 0.f, 0.f, 0.f};
#pragma unroll
                for (int s4 = 0; s4 < 4; ++s4) pacc = MFMA16(sp[s4], row_frag_perm(Wk, PQ, it * 16, s4 * 32, lane), pacc);
                const float v0 = bf_lo(cu[it].x) - pacc[0], v1 = bf_hi(cu[it].x) - pacc[1], v2 = bf_lo(cu[it].y) - pacc[2], v3 = bf_hi(cu[it].y) - pacc[3];
                u32x2 w; w.x = pkbf(v0, v1); w.y = pkbf(v2, v3);
                *(LAS u32x2*)(Vn + (it * 16 + l15) * PQ + (wid * 16 + 4 * kg) * 2) = w;
            }
            f32x4 oacc[4];
#pragma unroll
            for (int it = 0; it < 4; ++it) { oacc[it] = (f32x4){0.f, 0.f, 0.f, 0.f};
#pragma unroll
                for (int s4 = 0; s4 < 4; ++s4) oacc[it] = MFMA16(sp[s4], row_frag_perm(Qg, PQ, it * 16, s4 * 32, lane), oacc[it]); }
            bf16x8 vf[2];
#pragma unroll
            for (int ks = 0; ks < 2; ++ks) vf[ks] = tr_frag(Vn, PQ, ks * 32, wid * 16, lane);
#pragma unroll
            for (int it = 0; it < 4; ++it)
#pragma unroll
                for (int ks = 0; ks < 2; ++ks) if (ks == 0 || it >= 2) oacc[it] = MFMA16(vf[ks], row_frag(At, PA, it * 16, ks * 32, lane), oacc[it]);
#pragma unroll
            for (int dt = 0; dt < 8; ++dt) { S[dt] *= cgl;
#pragma unroll
                for (int ks = 0; ks < 2; ++ks) S[dt] = MFMA16(tr_frag(Kg, PQ, ks * 32, dt * 16, lane), vf[ks], S[dt]); }
#pragma unroll
            for (int it = 0; it < 4; ++it) {
                float sq = oacc[it][0] * oacc[it][0] + oacc[it][1] * oacc[it][1] + oacc[it][2] * oacc[it][2] + oacc[it][3] * oacc[it][3];
                sq += __shfl_xor(sq, 16); sq += __shfl_xor(sq, 32);
                if (kg == 0) part[(it * 16 + l15) * 8 + wid] = sq;
            }
            __syncthreads();
#pragma unroll
            for (int it = 0; it < 4; ++it) {
                const f32x4 p0 = *(LAS const f32x4*)(part + (it * 16 + l15) * 8), p1 = *(LAS const f32x4*)(part + (it * 16 + l15) * 8 + 4);
                const float rn = rsqrtf(((p0[0] + p0[1]) + (p0[2] + p0[3]) + (p1[0] + p1[1]) + (p1[2] + p1[3])) * (1.0f / 128.0f) + RMS_EPS);
                const f32x4 o = oacc[it] * rn * ng;
                u32x2 w; w.x = pkbf(o[0] * fsilu(bf_lo(cz[it].x)), o[1] * fsilu(bf_hi(cz[it].x))); w.y = pkbf(o[2] * fsilu(bf_lo(cz[it].y)), o[3] * fsilu(bf_hi(cz[it].y)));
                *(u32x2*)(O + (size_t)(b * T + n * 64 + it * 16 + l15) * D + h * 128 + wid * 16 + 4 * kg) = w;
            }
        }
#undef GDN_LOAD
        float* dst = p.out() + O_GP + (size_t)(b * 8 + h) * 128 * 128;
#pragma unroll
        for (int dt = 0; dt < 8; ++dt)
#pragma unroll
            for (int r = 0; r < 4; ++r) dst[(size_t)(dt * 16 + 4 * kg + r) * 128 + wid * 16 + l15] = S[dt][r];
    } else {
        LAS float* qs = (LAS float*)lds; LAS float* ks = qs + 128; LAS float* vs = ks + 128; LAS float* ob = vs + 128; LAS float* sc = ob + 128;
        const int col = wid * 16 + l15, d0 = kg * 32;
        const float* convw = p.in(9); const float* sconv = p.in(3);
        for (int it = bid - n_prompt; it < NS * 8; it += G - n_prompt) {
            const int h = it & 7, sq = it >> 3, r = MPR + sq;
            if (tid < 384) {
                const int part = tid >> 7, dd = tid & 127, gch = part * 1024 + h * 128 + dd;
                float a = convw[3 * CCH + gch] * bf2f(PROJ[(size_t)r * 4096 + gch]);
#pragma unroll
                for (int j = 0; j < 3; ++j) a += convw[j * CCH + gch] * sconv[((size_t)sq * 3 + j) * CCH + gch];
                (part == 0 ? qs : (part == 1 ? ks : vs))[dd] = fsilu(a);
            }
            if (tid == 0) { const float x = PROJS[(size_t)r * 16 + 8 + h] + p.in(11)[h]; const float sp = x > 20.f ? x : log1pf(__expf(x));
                sc[0] = fsigmoid(PROJS[(size_t)r * 16 + h]); sc[1] = __expf(-__expf(p.in(10)[h]) * sp); }
            const float* s0 = p.in(4) + ((size_t)(sq * 8 + h) * 128 + d0) * 128 + col;
            float S[32];
#pragma unroll
            for (int dd = 0; dd < 32; ++dd) S[dd] = s0[(size_t)dd * 128];
            __syncthreads();
            if (wid == 0) {
                float q0 = qs[lane], q1 = qs[64 + lane], k0 = ks[lane], k1 = ks[64 + lane];
                const float qn = rsqrtf(wave_sum(q0 * q0 + q1 * q1) + RMS_EPS) * 0.088388347648318f, kn = rsqrtf(wave_sum(k0 * k0 + k1 * k1) + RMS_EPS);
                q0 *= qn; q1 *= qn; k0 *= kn; k1 *= kn;
                qs[lane] = q0; qs[64 + lane] = q1; ks[lane] = k0; ks[64 + lane] = k1;
                const float dt = wave_sum(q0 * k0 + q1 * k1);
                if (lane == 0) sc[2] = dt;
            }
            __syncthreads();
            float rp = 0.f, pp = 0.f;
#pragma unroll
            for (int dd = 0; dd < 32; ++dd) { rp += ks[d0 + dd] * S[dd]; pp += qs[d0 + dd] * S[dd]; }
            rp += __shfl_xor(rp, 16); rp += __shfl_xor(rp, 32); pp += __shfl_xor(pp, 16); pp += __shfl_xor(pp, 32);
            const float beta = sc[0], a = sc[1], qk = sc[2];
            const float vnew = beta * (vs[col] - a * rp);
            float* dst = p.out() + O_GS + ((size_t)(sq * 8 + h) * 128 + d0) * 128 + col;
#pragma unroll
            for (int dd = 0; dd < 32; ++dd) dst[(size_t)dd * 128] = a * S[dd] + ks[d0 + dd] * vnew;
            if (kg == 0) ob[col] = a * pp + qk * vnew;
            __syncthreads();
            if (wid == 0) {
                const float o0 = ob[lane], o1 = ob[64 + lane];
                const float rn = rsqrtf(wave_sum(o0 * o0 + o1 * o1) * (1.0f / 128.0f) + RMS_EPS);
                const float z0 = bf2f(PROJ[(size_t)r * 4096 + 3072 + h * 128 + lane]), z1 = bf2f(PROJ[(size_t)r * 4096 + 3072 + h * 128 + 64 + lane]);
                O[(size_t)r * D + h * 128 + lane] = f2bf(o0 * rn * norm_g[lane] * fsilu(z0));
                O[(size_t)r * D + h * 128 + 64 + lane] = f2bf(o1 * rn * norm_g[64 + lane] * fsilu(z1));
            }
            __syncthreads();
        }
    }
    const float* sconv2 = p.in(3);
    for (int idx = bid * 512 + tid; idx < NB * 3 * CCH; idx += G * 512) { const int b2 = idx / (3 * CCH), j = (idx / CCH) % 3, ch = idx % CCH;
        p.out()[O_CP + idx] = bf2f(PROJ[(size_t)(b2 * T + T - 3 + j) * 4096 + ch]); }
    for (int idx = bid * 512 + tid; idx < NS * 3 * CCH; idx += G * 512) { const int i = idx / (3 * CCH), j = (idx / CCH) % 3, ch = idx % CCH;
        p.out()[O_CS + idx] = j < 2 ? sconv2[((size_t)i * 3 + j + 1) * CCH + ch] : bf2f(PROJ[(size_t)(MPR + i) * 4096 + ch]); }
}

__device__ void ret_scan_phase(const Ctx& p, LAS unsigned char* lds) {
    constexpr int PQ = 272, PV = 528, PA = 144;
    unsigned char* ws = p.ws();
    const bf16_t* PR = (const bf16_t*)(ws + WS_BIG); bf16_t* O2 = (bf16_t*)(ws + WS_O);
    const int tid = opaque_tid(), lane = tid & 63, wid = __builtin_amdgcn_readfirstlane(tid >> 6), kg = lane >> 4, l15 = lane & 15;
    const int G = gridDim.x, bid = blockIdx.x;
    const int n_prompt = (G > 64) ? 64 : 0;
    if (bid < n_prompt) {
        LAS unsigned char* Qs = lds; LAS unsigned char* Ks = Qs + 64 * PQ; LAS unsigned char* Kz = Ks + 64 * PQ; LAS unsigned char* Vs = Kz + 64 * PQ; LAS unsigned char* At = Vs + 64 * PV;
        LAS float* part = (LAS float*)(At + 64 * PA); LAS float* pw = part + 64 * 8 * 2;
        const int b = bid >> 3, h = bid & 7;
        const float lg2 = log2f(1.0f - exp2f(-5.0f - (float)h));
        if (tid <= 64) pw[tid] = exp2f((float)tid * lg2);
        for (int i = tid; i < 64 * PA / 4; i += 512) ((LAS unsigned*)At)[i] = 0u;
        f32x4 S[8][2];
#pragma unroll
        for (int dt = 0; dt < 8; ++dt) { S[dt][0] = (f32x4){0.f, 0.f, 0.f, 0.f}; S[dt][1] = S[dt][0]; }
        const int lrow = tid >> 3, lseg = tid & 7;
        u32x4 rq[2], rk[2], rv[4];
        const bf16_t* gsrc = PR + (size_t)(b * T + lrow) * RIN;
#define RET_LOAD(n) do { const bf16_t* g_ = gsrc + (size_t)(n) * 64 * RIN; \
            rq[0] = *(const u32x4*)(g_ + h * 128 + lseg * 16); rq[1] = *(const u32x4*)(g_ + h * 128 + lseg * 16 + 8); \
            rk[0] = *(const u32x4*)(g_ + 1024 + h * 128 + lseg * 16); rk[1] = *(const u32x4*)(g_ + 1024 + h * 128 + lseg * 16 + 8); \
            _Pragma("unroll") for (int e = 0; e < 4; ++e) rv[e] = *(const u32x4*)(g_ + 2048 + h * 256 + lseg * 32 + e * 8); } while (0)
        RET_LOAD(0);
        __syncthreads();
        const float gC = pw[64];
        for (int n = 0; n < T / 64; ++n) {
            {
                const float z = pw[63 - lrow];
#pragma unroll
                for (int e = 0; e < 2; ++e) {
                    *(LAS u32x4*)(Qs + lrow * PQ + (lseg * 16 + e * 8) * 2) = rq[e];
                    *(LAS u32x4*)(Ks + lrow * PQ + (lseg * 16 + e * 8) * 2) = rk[e];
                    u32x4 kz; kz.x = pkbf(bf_lo(rk[e].x) * z, bf_hi(rk[e].x) * z); kz.y = pkbf(bf_lo(rk[e].y) * z, bf_hi(rk[e].y) * z);
                    kz.z = pkbf(bf_lo(rk[e].z) * z, bf_hi(rk[e].z) * z); kz.w = pkbf(bf_lo(rk[e].w) * z, bf_hi(rk[e].w) * z);
                    *(LAS u32x4*)(Kz + lrow * PQ + (lseg * 16 + e * 8) * 2) = kz;
                }
#pragma unroll
                for (int e = 0; e < 4; ++e) *(LAS u32x4*)(Vs + lrow * PV + (lseg * 32 + e * 8) * 2) = rv[e];
            }
            __syncthreads();
            if (n + 1 < T / 64) RET_LOAD(n + 1);
            for (int u = wid; u < 10; u += 8) {
                const int it = u < 1 ? 0 : (u < 3 ? 1 : (u < 6 ? 2 : 3)), jt = u - (it * (it + 1)) / 2;
                f32x4 acc = (f32x4){0.f, 0.f, 0.f, 0.f};
#pragma unroll
                for (int ks = 0; ks < 4; ++ks) acc = MFMA16(row_frag(Ks, PQ, jt * 16, ks * 32, lane), row_frag(Qs, PQ, it * 16, ks * 32, lane), acc);
                const int i = it * 16 + l15, j0 = jt * 16 + 4 * kg;
                float v[4];
#pragma unroll
                for (int r = 0; r < 4; ++r) { const int dd = i - (j0 + r); v[r] = dd >= 0 ? acc[r] * pw[dd < 0 ? 0 : dd] : 0.f; }
                u32x2 o; o.x = pkbf(v[0], v[1]); o.y = pkbf(v[2], v[3]);
                *(LAS u32x2*)(At + i * PA + j0 * 2) = o;
            }
            __syncthreads();
            f32x4 acc[2][4];
#pragma unroll
            for (int ct = 0; ct < 2; ++ct)
#pragma unroll
                for (int it = 0; it < 4; ++it) acc[ct][it] = (f32x4){0.f, 0.f, 0.f, 0.f};
#pragma unroll
            for (int s4 = 0; s4 < 4; ++s4) {
                const bf16x8 a0 = pack_acc_pair(S[2 * s4][0], S[2 * s4 + 1][0]), a1 = pack_acc_pair(S[2 * s4][1], S[2 * s4 + 1][1]);
#pragma unroll
                for (int it = 0; it < 4; ++it) { const bf16x8 bq = row_frag_perm(Qs, PQ, it * 16, s4 * 32, lane);
                    acc[0][it] = MFMA16(a0, bq, acc[0][it]); acc[1][it] = MFMA16(a1, bq, acc[1][it]); }
            }
#pragma unroll
            for (int it = 0; it < 4; ++it) { const float xi = pw[it * 16 + l15 + 1]; acc[0][it] *= xi; acc[1][it] *= xi; }
            bf16x8 vf[2][2];
#pragma unroll
            for (int ct = 0; ct < 2; ++ct)
#pragma unroll
                for (int ks = 0; ks < 2; ++ks) vf[ct][ks] = tr_frag(Vs, PV, ks * 32, wid * 32 + ct * 16, lane);
#pragma unroll
            for (int it = 0; it < 4; ++it)
#pragma unroll
                for (int ks = 0; ks < 2; ++ks) if (ks == 0 || it >= 2) { const bf16x8 ba = row_frag(At, PA, it * 16, ks * 32, lane);
                    acc[0][it] = MFMA16(vf[0][ks], ba, acc[0][it]); acc[1][it] = MFMA16(vf[1][ks], ba, acc[1][it]); }
#pragma unroll
            for (int dt = 0; dt < 8; ++dt) { S[dt][0] *= gC; S[dt][1] *= gC;
#pragma unroll
                for (int ks = 0; ks < 2; ++ks) { const bf16x8 ak = tr_frag(Kz, PQ, ks * 32, dt * 16, lane);
                    S[dt][0] = MFMA16(ak, vf[0][ks], S[dt][0]); S[dt][1] = MFMA16(ak, vf[1][ks], S[dt][1]); } }
            u32x2 gt[2][4];
#pragma unroll
            for (int it = 0; it < 4; ++it) { const size_t r = (size_t)(b * T + n * 64 + it * 16 + l15);
#pragma unroll
                for (int ct = 0; ct < 2; ++ct) gt[ct][it] = *(const u32x2*)(PR + r * RIN + 4096 + h * 256 + wid * 32 + ct * 16 + 4 * kg); }
#pragma unroll
            for (int it = 0; it < 4; ++it) {
                float sm = 0.f, sq = 0.f;
#pragma unroll
                for (int ct = 0; ct < 2; ++ct)
#pragma unroll
                    for (int r = 0; r < 4; ++r) { const float x = acc[ct][it][r]; sm += x; sq += x * x; }
                sm += __shfl_xor(sm, 16); sm += __shfl_xor(sm, 32); sq += __shfl_xor(sq, 16); sq += __shfl_xor(sq, 32);
                if (kg == 0) *(LAS f32x2*)(part + ((it * 16 + l15) * 8 + wid) * 2) = (f32x2){sm, sq};
            }
            __syncthreads();
#pragma unroll
            for (int it = 0; it < 4; ++it) {
                const int i = it * 16 + l15;
                float sm = 0.f, sq = 0.f;
#pragma unroll
                for (int e = 0; e < 4; ++e) { const f32x4 v = *(LAS const f32x4*)(part + i * 16 + e * 4); sm += v.x; sq += v.y; sm += v.z; sq += v.w; }
                const float mean = sm * (1.0f / 256.0f), rs = rsqrtf(fmaxf(sq * (1.0f / 256.0f) - mean * mean, 0.f) + LN_EPS);
                const size_t r = (size_t)(b * T + n * 64 + i);
#pragma unroll
                for (int ct = 0; ct < 2; ++ct) {
                    const f32x4 o = (acc[ct][it] - mean) * rs; const u32x2 g2 = gt[ct][it];
                    u32x2 w; w.x = pkbf(fsilu(bf_lo(g2.x)) * o[0], fsilu(bf_hi(g2.x)) * o[1]); w.y = pkbf(fsilu(bf_lo(g2.y)) * o[2], fsilu(bf_hi(g2.y)) * o[3]);
                    *(u32x2*)(O2 + r * 2048 + h * 256 + wid * 32 + ct * 16 + 4 * kg) = w;
                }
            }
        }
#undef RET_LOAD
        float* dst = p.out() + O_RP + (size_t)(b * 8 + h) * 128 * 256;
#pragma unroll
        for (int dt = 0; dt < 8; ++dt)
#pragma unroll
            for (int ct = 0; ct < 2; ++ct)
#pragma unroll
                for (int r = 0; r < 4; ++r) dst[(size_t)(dt * 16 + 4 * kg + r) * 256 + wid * 32 + ct * 16 + l15] = S[dt][ct][r];
        return;
    }
    {
        LAS float* qs = (LAS float*)lds; LAS float* ks = qs + 128; LAS float* op = ks + 128;
        const int col = tid & 255, half = tid >> 8, d0 = half * 64;
        for (int it = bid - n_prompt; it < NS * 8; it += G - n_prompt) {
            const int h = it & 7, sq = it >> 3; const size_t rb = (size_t)(MPR + sq) * RIN;
            const float gamma = 1.0f - exp2f(-5.0f - (float)h);
            if (tid < 128) { qs[tid] = bf2f(PR[rb + h * 128 + tid]); ks[tid] = bf2f(PR[rb + 1024 + h * 128 + tid]); }
            const float v = bf2f(PR[rb + 2048 + h * 256 + col]);
            const float* s0 = p.in(5) + ((size_t)(sq * 8 + h) * 128 + d0) * 256 + col;
            float* dst = p.out() + O_RS + ((size_t)(sq * 8 + h) * 128 + d0) * 256 + col;
            __syncthreads();
            float o = 0.f;
#pragma unroll 8
            for (int dd = 0; dd < 64; ++dd) { const float sv = gamma * s0[(size_t)dd * 256] + ks[d0 + dd] * v; dst[(size_t)dd * 256] = sv; o += qs[d0 + dd] * sv; }
            op[half * 256 + col] = o;
            __syncthreads();
            if (tid < 64) {
                float ov[4]; float s = 0.f;
#pragma unroll
                for (int j = 0; j < 4; ++j) { ov[j] = op[lane + 64 * j] + op[256 + lane + 64 * j]; s += ov[j]; }
                const float mean = wave_sum(s) * (1.0f / 256.0f);
                float q = 0.f;
#pragma unroll
                for (int j = 0; j < 4; ++j) { ov[j] -= mean; q += ov[j] * ov[j]; }
                const float rs = rsqrtf(wave_sum(q) * (1.0f / 256.0f) + LN_EPS);
#pragma unroll
                for (int j = 0; j < 4; ++j) { const float gt = bf2f(PR[rb + 4096 + h * 256 + lane + 64 * j]); O2[(size_t)(MPR + sq) * 2048 + h * 256 + lane + 64 * j] = f2bf(fsilu(gt) * ov[j] * rs); }
            }
            __syncthreads();
        }
    }
}

__device__ void final_ln_phase(const Ctx& p, const bf16_t* y, const float* st, const float* lg, const float* lb) {
    const int tid = opaque_tid();
    for (size_t e = (size_t)blockIdx.x * 512 + tid; e < (size_t)MR * (D / 8); e += (size_t)gridDim.x * 512) {
        const int r = (int)(e >> 7), c0 = (int)(e & 127) * 8;
        float mu, rstd; ln_stats(st, r, mu, rstd);
        const u32x4 w = *(const u32x4*)(y + (size_t)r * D + c0);
        f32x4 x0 = (f32x4){bf_lo(w.x), bf_hi(w.x), bf_lo(w.y), bf_hi(w.y)}, x1 = (f32x4){bf_lo(w.z), bf_hi(w.z), bf_lo(w.w), bf_hi(w.w)};
        x0 = (x0 - mu) * rstd * *(const f32x4*)(lg + c0) + *(const f32x4*)(lb + c0);
        x1 = (x1 - mu) * rstd * *(const f32x4*)(lg + c0 + 4) + *(const f32x4*)(lb + c0 + 4);
        float* dst = p.out() + (r < MPR ? O_YP + (size_t)r * D : O_YS + (size_t)(r - MPR) * D) + c0;
        *(f32x4*)dst = x0; *(f32x4*)(dst + 4) = x1;
    }
}

__global__ void __launch_bounds__(512, 2) fwd_megakernel(Params kp) {
    extern __shared__ __attribute__((aligned(16))) unsigned char lds_raw[];
    LAS unsigned char* lds = (LAS unsigned char*)lds_raw;
    cg::grid_group grid = cg::this_grid();
    if (threadIdx.x == 0) {
        LAS unsigned long long* tb = (LAS unsigned long long*)(lds + PTAB_OFF);
#pragma unroll
        for (int i = 0; i < 20; ++i) tb[i] = (unsigned long long)kp.in[i];
        tb[20] = (unsigned long long)kp.out; tb[21] = (unsigned long long)kp.ws;
    }
    __syncthreads();
    Ctx p; p.tab = (const LAS unsigned*)(lds + PTAB_OFF);
    int ph0 = kp.ph_lo; bool need_sync = false;
    if (ph0 == 0) { if (EN(0)) prep_phase(p, lds); ph0 = 1; need_sync = true; }
    for (int pi = ph0; pi < kp.ph_hi; ++pi) {
        const int ph = pi <= 5 ? pi : (pi == 6 ? 19 : pi - 1);
        if (need_sync) grid.sync();
        need_sync = true;
        __syncthreads();
        if (ph == 5) { if (EN(5)) gdn_phase_a(p, lds); continue; }
        if (ph == 19) { if (EN(5)) gdn_phase_b(p, lds); continue; }
        if (ph == 10) { if (EN(10)) ret_scan_phase(p, lds); continue; }
        unsigned char* ws = p.ws();
        float* stats = (float*)(ws + WS_STATS);
        const float* ln_g = p.in(18); const float* ln_b = p.in(19);
#define YBUF(s) ((bf16_t*)(ws + (((s) & 1) ? WS_YB : WS_YA)))
#define STATS(s) (stats + (size_t)(s) * MP * 32)
        if (ph == 14) { if (EN(14)) pool_stencil_phase<3>(p, 1, YBUF(5), STATS(5), ln_g + 5 * D, ln_b + 5 * D, (bf16_t*)(ws + WS_O)); continue; }
        if (ph == 18) { if (EN(18)) final_ln_phase(p, YBUF(7), STATS(7), ln_g + 7 * D, ln_b + 7 * D); continue; }
        const int layer = ph <= 3 ? 0 : (ph <= 8 ? 1 : (ph <= 13 ? 2 : 3));
        int kind, lda = D, K = 1024, nN = 4, apn = 0, sin = 0, sout = 0, coff = 0;
        size_t aoff = WS_O, boff = 0;
        if (ph == 1 || ph == 15) { kind = ph == 1 ? E_RES_IN : E_RES_LN; K = 256; apn = 512; boff = WS_WPOOL + (size_t)(ph == 1 ? 0 : 1) * 4 * 65536 * 2; sin = 5; sout = ph == 1 ? 0 : 6; }
        else if (ph == 2 || ph == 7 || ph == 12 || ph == 16) { kind = E_SWIGLU; sin = 2 * layer; aoff = (sin & 1) ? WS_YB : WS_YA; boff = WS_W13 + (size_t)layer * 5632 * 1024 * 2; nN = 22; coff = layer * 5632; }
        else if (ph == 3 || ph == 8 || ph == 13 || ph == 17) { kind = E_RES_LN; sin = 2 * layer; sout = sin + 1; aoff = WS_BIG; lda = DFF; K = DFF; boff = WS_W2 + (size_t)layer * 1024 * 2816 * 2; }
        else if (ph == 4) { kind = E_GDN; sin = 1; aoff = WS_YB; boff = WS_WGI; nN = GINP / 256; coff = 4 * 5632; }
        else if (ph == 6) { kind = E_RES_LN; sin = 1; sout = 2; boff = WS_WGO; }
        else if (ph == 9) { kind = E_RET; sin = 3; aoff = WS_YB; boff = WS_WRI; nN = RIN / 256; coff = 4 * 5632 + GINP; }
        else   { kind = E_RES_LN; sin = 3; sout = 4; lda = 2048; K = 2048; boff = WS_WRO; }
        pg8::Gemm g{(const bf16_t*)(ws + aoff), (const bf16_t*)(ws + boff), lda, K, MP / 256, nN, apn};
        pg8::StaticOrder S; S.init(g.nM, g.nN, gridDim.x, blockIdx.x);
        if (kind == E_RES_IN) { if (EN(1)) { Epi<E_RES_IN> E{}; E.xp = p.in(0); E.xs = p.in(1); E.cscale = p.in(7); E.st_out = STATS(0); E.yout = YBUF(0); pg8::gemm_phase(lds, g, S, E); } }
        else if (kind == E_RES_LN) { if (EN(3)) { Epi<E_RES_LN> E{}; E.st_in = STATS(sin); E.yprev = YBUF(sin); E.lg = ln_g + (size_t)sin * D; E.lb = ln_b + (size_t)sin * D;
            E.cscale = ph == 15 ? p.in(7) + D : nullptr; E.st_out = STATS(sout); E.yout = YBUF(sout); pg8::gemm_phase(lds, g, S, E); } }
        else {
            const float* c1 = (const float*)(ws + WS_C1) + coff; const float* c2 = (const float*)(ws + WS_C2) + coff;
            if (kind == E_SWIGLU) { if (EN(2)) { Epi<E_SWIGLU> E{}; E.st_in = STATS(sin); E.c1 = c1; E.c2 = c2; E.ob = (bf16_t*)(ws + WS_BIG); pg8::gemm_phase(lds, g, S, E); } }
            else if (kind == E_GDN) { if (EN(4)) { Epi<E_GDN> E{}; E.st_in = STATS(sin); E.c1 = c1; E.c2 = c2; E.ob = (bf16_t*)(ws + WS_BIG); E.of = (float*)(ws + WS_PROJS); pg8::gemm_phase(lds, g, S, E); } }
            else { if (EN(9)) { Epi<E_RET> E{}; E.st_in = STATS(sin); E.c1 = c1; E.c2 = c2; E.ob = (bf16_t*)(ws + WS_BIG); E.rope = (const float*)(ws + WS_ROPE); pg8::gemm_phase(lds, g, S, E); } }
        }
    }
}

extern "C" void kernel_launch(void* const* d_in, const int* in_sizes, int n_in, void* d_out, int out_size, void* d_ws, size_t ws_size, hipStream_t stream) {
    static int grid = 0;
    if (grid == 0) {
        if (n_in != 20 || (size_t)out_size != O_END || ws_size < WS_END) { fprintf(stderr, "kernel_launch: unexpected shapes: n_in %d out %d (want %zu) ws %zu (want %zu)\n", n_in, out_size, (size_t)O_END, ws_size, (size_t)WS_END); grid = -1; return; }
        int dev = 0, cus = 0, per_cu = 0;
        hipGetDevice(&dev); hipDeviceGetAttribute(&cus, hipDeviceAttributeMultiprocessorCount, dev);
        if (hipFuncSetAttribute((const void*)fwd_megakernel, hipFuncAttributeMaxDynamicSharedMemorySize, LDS_BYTES) != hipSuccess) { fprintf(stderr, "kernel_launch: hipFuncSetAttribute failed\n"); grid = -1; return; }
        if (hipOccupancyMaxActiveBlocksPerMultiprocessor(&per_cu, (const void*)fwd_megakernel, 512, LDS_BYTES) != hipSuccess || per_cu < 1) { fprintf(stderr, "kernel_launch: occupancy query says %d\n", per_cu); per_cu = 1; }
        (void)hipGetLastError();
        grid = cus;
        fprintf(stderr, "kernel_launch: cus %d per_cu %d grid %d\n", cus, per_cu, grid);
    }
    if (grid < 0) return;
    Params p{};
    for (int i = 0; i < 20; ++i) p.in[i] = (const float*)d_in[i];
    p.out = (float*)d_out; p.ws = (unsigned char*)d_ws;
#if N_LAUNCHES == 1
    p.ph_lo = 0; p.ph_hi = NPH;
    void* args[] = {&p};
    hipError_t e = hipLaunchCooperativeKernel((const void*)fwd_megakernel, dim3(grid), dim3(512), args, LDS_BYTES, stream);
    if (e != hipSuccess) fprintf(stderr, "cooperative launch failed: %s (grid %d)\n", hipGetErrorString(e), grid);
#else
    for (int ph = 0; ph < NPH; ++ph) {
        p.ph_lo = ph; p.ph_hi = ph + 1;
        hipLaunchKernelGGL(fwd_megakernel, dim3(grid), dim3(512), LDS_BYTES, stream, p);
    }
#endif
}
```

```cpp
#include <hip/hip_runtime.h>
#include <hip/hip_cooperative_groups.h>
#include <cstdio>
namespace cg = cooperative_groups;

#ifndef N_LAUNCHES
#define N_LAUNCHES 1
#endif

#ifndef PH_MASK
#define PH_MASK 0x7ffff
#endif
#define EN(x) (((PH_MASK) >> (x)) & 1)
#ifndef PROBE_MASK
#define PROBE_MASK 0
#endif
#define LAS __attribute__((address_space(3)))
typedef unsigned short bf16_t;
typedef short bf16x8 __attribute__((ext_vector_type(8)));
typedef float f32x4 __attribute__((ext_vector_type(4)));
typedef float f32x2 __attribute__((ext_vector_type(2)));
typedef unsigned u32x4 __attribute__((ext_vector_type(4)));
typedef unsigned u32x2 __attribute__((ext_vector_type(2)));

constexpr int D = 1024, NB = 8, T = 2048, MPR = NB * T, NS = 128, MR = MPR + NS, MP = 16640;
constexpr int DFF = 2816, GIN = 4112, GINP = 4352, RIN = 6144, PBUF = 15, CCH = 3072;
constexpr float DN_ALPHA = 1.6817928305074290f;
constexpr float LN_EPS = 1e-5f, RMS_EPS = 1e-6f;
constexpr int NPH = 20;
constexpr int LDS_BYTES = 147456;

constexpr size_t O_YP = 0;
constexpr size_t O_YS = O_YP + (size_t)MPR * D;
constexpr size_t O_PP = O_YS + (size_t)NS * D;
constexpr size_t O_PS = O_PP + (size_t)2 * NB * PBUF * D;
constexpr size_t O_CP = O_PS + (size_t)2 * NS * PBUF * D;
constexpr size_t O_CS = O_CP + (size_t)NB * 3 * CCH;
constexpr size_t O_GP = O_CS + (size_t)NS * 3 * CCH;
constexpr size_t O_GS = O_GP + (size_t)NB * 8 * 128 * 128;
constexpr size_t O_RP = O_GS + (size_t)NS * 8 * 128 * 128;
constexpr size_t O_RS = O_RP + (size_t)NB * 8 * 128 * 256;
constexpr size_t O_END = O_RS + (size_t)NS * 8 * 128 * 256;

constexpr size_t al256(size_t x) { return (x + 255) & ~(size_t)255; }
constexpr size_t WS_STATS = 0;
constexpr size_t NCFOLD = 4 * 5632 + GINP + RIN;
constexpr size_t WS_C1 = al256(WS_STATS + (size_t)8 * MP * 32 * 4);
constexpr size_t WS_C2 = al256(WS_C1 + NCFOLD * 4);
constexpr size_t WS_ZERO_END = al256(WS_C2 + NCFOLD * 4);
constexpr size_t WS_WPOOL = WS_ZERO_END;
constexpr size_t WS_W13 = al256(WS_WPOOL + (size_t)2 * 4 * 256 * 256 * 2);
constexpr size_t WS_W2 = al256(WS_W13 + (size_t)4 * 5632 * 1024 * 2);
constexpr size_t WS_WGI = al256(WS_W2 + (size_t)4 * 1024 * 2816 * 2);
constexpr size_t WS_WGO = al256(WS_WGI + (size_t)GINP * 1024 * 2);
constexpr size_t WS_WRI = al256(WS_WGO + (size_t)1024 * 1024 * 2);
constexpr size_t WS_WRO = al256(WS_WRI + (size_t)RIN * 1024 * 2);
constexpr size_t WS_ROPE = al256(WS_WRO + (size_t)1024 * 2048 * 2);
constexpr size_t WS_YA = al256(WS_ROPE + (size_t)2049 * 64 * 2 * 4);
constexpr size_t WS_YB = al256(WS_YA + (size_t)MP * D * 2);
constexpr size_t WS_O = al256(WS_YB + (size_t)MP * D * 2);
constexpr size_t WS_PROJS = al256(WS_O + (size_t)MP * 2048 * 2);
constexpr size_t WS_BIG = al256(WS_PROJS + (size_t)MP * 16 * 4);
constexpr size_t WS_GAT = al256(WS_BIG + (size_t)MP * RIN * 2);
constexpr size_t WS_GGL = al256(WS_GAT + (size_t)2048 * 64 * 64 * 2);
constexpr size_t WS_END = al256(WS_GGL + (size_t)2048 * 4);
constexpr size_t WS_GWK = WS_YA;
constexpr size_t WS_GQG = WS_O + (size_t)MP * D * 2;
constexpr size_t WS_GKG = WS_BIG + (size_t)MP * 4096 * 2;
constexpr size_t WS_GU = WS_GKG + (size_t)2048 * 64 * 128 * 2;
static_assert((size_t)2048 * 64 * 128 * 2 <= (size_t)MP * D * 2, "gdn scratch");
static_assert(WS_GU + (size_t)2048 * 64 * 128 * 2 <= WS_BIG + (size_t)MP * RIN * 2, "gdn scratch");

struct Params { const float* in[20]; float* out; unsigned char* ws; int ph_lo, ph_hi; };
constexpr int PTAB_OFF = 144 * 1024 - 256;
struct Ctx {
    const unsigned __attribute__((address_space(3)))* tab;
    __device__ __forceinline__ unsigned long long raw(int i) const {
        const unsigned lo = __builtin_amdgcn_readfirstlane(tab[2 * i]), hi = __builtin_amdgcn_readfirstlane(tab[2 * i + 1]);
        return ((unsigned long long)hi << 32) | lo; }
    __device__ __forceinline__ const float* in(int i) const { return (const float*)raw(i); }
    __device__ __forceinline__ float* out() const { return (float*)raw(20); }
    __device__ __forceinline__ unsigned char* ws() const { return (unsigned char*)raw(21); }
};

__device__ __forceinline__ unsigned cvt_pk_bf16(float lo, float hi) { unsigned r; asm("v_cvt_pk_bf16_f32 %0, %1, %2" : "=v"(r) : "v"(lo), "v"(hi)); return r; }
__device__ __forceinline__ float bf_lo(unsigned w) { return __uint_as_float(w << 16); }
__device__ __forceinline__ float bf_hi(unsigned w) { return __uint_as_float(w & 0xffff0000u); }
__device__ __forceinline__ float bf2f(bf16_t b) { return __uint_as_float(((unsigned)b) << 16); }
__device__ __forceinline__ bf16_t f2bf(float f) { return (bf16_t)(cvt_pk_bf16(f, 0.f) & 0xffffu); }
__device__ __forceinline__ float fsigmoid(float x) { return __builtin_amdgcn_rcpf(1.0f + __expf(-x)); }
__device__ __forceinline__ float fsilu(float x) { return x * fsigmoid(x); }
__device__ __forceinline__ int opaque_tid() { int t = threadIdx.x; asm volatile("" : "+v"(t)); return t; }
__device__ __forceinline__ float wave_sum(float v) {
#pragma unroll
    for (int o = 32; o >= 1; o >>= 1) v += __shfl_xor(v, o);
    return v;
}
__device__ __forceinline__ void ln_finish(float s, float q, float& mu, float& rstd) {
    mu = s * (1.0f / 1024.0f);
    const float var = fmaxf(q * (1.0f / 1024.0f) - mu * mu, 0.f);
    rstd = rsqrtf(var + LN_EPS);
}
__device__ __forceinline__ void ln_stats(const float* st, int r, float& mu, float& rstd) {
    const f32x4* sp = (const f32x4*)(st + 32 * (size_t)r);
    float s = 0.f, q = 0.f;
#pragma unroll
    for (int i = 0; i < 8; ++i) { const f32x4 v = sp[i]; s += v.x; q += v.y; s += v.z; q += v.w; }
    ln_finish(s, q, mu, rstd);
}
__device__ __forceinline__ void ln_stats4(const float* st, int r, int fq, float& mu, float& rstd) {
    const f32x4* sp = (const f32x4*)(st + 32 * (size_t)r) + 2 * fq;
    const f32x4 v0 = sp[0], v1 = sp[1];
    float s = (v0.x + v0.z) + (v1.x + v1.z), q = (v0.y + v0.w) + (v1.y + v1.w);
    s += __shfl_xor(s, 16); q += __shfl_xor(q, 16); s += __shfl_xor(s, 32); q += __shfl_xor(q, 32);
    ln_finish(s, q, mu, rstd);
}

namespace pg8 {
constexpr int BM = 256, BK = 64, HALF = 128, HTB = HALF * BK * 2, STAGE_BYTES = 8 * HTB, NXCD = 8, WGM = 8;
__device__ __forceinline__ int lds_byte(int r, int c) { const int st = (r >> 4) * 2 + (c >> 5), rr = r & 15, cc = c & 31, ob = rr * 64 + cc * 2; return st * 1024 + (ob ^ (((ob >> 9) & 1) << 5)); }
__device__ __forceinline__ void stage_rc(int b, int& R, int& C) { const int st = b / 1024, sb = b % 1024, swz = sb ^ (((sb >> 9) & 1) << 5); R = (st >> 1) * 16 + swz / 64; C = (st & 1) * 32 + (swz % 64) / 2; }
__device__ __forceinline__ int perm32(int rho) { const int n = rho >> 4, i = rho & 15; return 8 * (i >> 2) + 4 * n + (i & 3); }

struct Unit { int pm, pn; };
struct Gemm { const bf16_t* A; const bf16_t* Bt; int lda, K, nM, nN, apn; };

struct StaticOrder {
    int nM, nN, nwg, G, c;
    __device__ void init(int nM_, int nN_, int G_, int c_) { nM = nM_; nN = nN_; nwg = nM * nN; G = G_; c = c_; }
    __device__ bool next(int i, Unit& u) const {
        const long L = (long)i * G + c; if (L >= nwg) return false;
        int wgid = (int)L; { const int q = nwg / NXCD, r = nwg % NXCD, xcd = wgid % NXCD, off = wgid / NXCD; wgid = (xcd < r ? xcd * (q + 1) : r * (q + 1) + (xcd - r) * q) + off; }
        const int nig = WGM * nN, gid = wgid / nig, fm = gid * WGM, gsz = (nM - fm) < WGM ? (nM - fm) : WGM;
        u.pm = fm + ((wgid % nig) % gsz); u.pn = (wgid % nig) / gsz; return true;
    }
};

template <class Epi>
__device__ __forceinline__ void gemm_phase(LAS unsigned char* lds, const Gemm g, const StaticOrder& S, const Epi& E) {
    int tid_ = threadIdx.x; asm volatile("" : "+v"(tid_));
    const int tid = tid_, wid = __builtin_amdgcn_readfirstlane(tid >> 6), lane = tid & 63, wr = wid >> 2, wc = wid & 3, fr = lane & 15, fq = lane >> 4;
    const int K = g.K, nt = K / BK;
    unsigned voffA[2], voffB[2];
#pragma unroll
    for (int i = 0; i < 2; ++i) { int R, C; stage_rc(tid * 16 + i * 8192, R, C); const int Rb = (R & ~31) + perm32(R & 31);
        voffA[i] = (unsigned)(R * g.lda + C) * 2u; voffB[i] = (unsigned)(Rb * K + C) * 2u; }
    const size_t kstep = (size_t)(BK * 2);
    const size_t hstepA = (size_t)HALF * g.lda * 2, hstepB = (size_t)HALF * K * 2;
    const size_t tstepA = 2 * hstepA, tstepB = 2 * hstepB;
    const unsigned ldsw = (unsigned)wid * 1024u;
    const int aoff = lds_byte(wr * 64 + fr, fq * 8), boff = lds_byte(wc * 32 + fr, fq * 8);
#define PG8_SA(b, h) (((b) * 2 + (h)) * HTB)
#define PG8_SB(b, h) ((4 + (b) * 2 + (h)) * HTB)
#define PG8_STAGE(bufoff, gbase, voff) do { _Pragma("unroll") for (int _i = 0; _i < 2; ++_i) \
        __builtin_amdgcn_global_load_lds((const unsigned*)((const char*)(gbase) + (voff)[_i]), (LAS unsigned*)(lds + (bufoff) + ldsw + _i * 8192), 16, 0, 0); } while (0)
#define PG8_LDA(dst, b, h) do { _Pragma("unroll") for (int m = 0; m < 4; ++m) _Pragma("unroll") for (int k = 0; k < 2; ++k) dst[m][k] = *(const LAS bf16x8*)(lds + PG8_SA(b, h) + aoff + m * 2048 + k * 1024); } while (0)
#define PG8_LDB(dst, b, h) do { _Pragma("unroll") for (int n = 0; n < 2; ++n) _Pragma("unroll") for (int k = 0; k < 2; ++k) dst[n][k] = *(const LAS bf16x8*)(lds + PG8_SB(b, h) + boff + n * 2048 + k * 1024); } while (0)
#define PG8_MMA(ai, bj, At, Bt) do { __builtin_amdgcn_s_setprio(1); _Pragma("unroll") for (int m = 0; m < 4; ++m) _Pragma("unroll") for (int n = 0; n < 2; ++n) _Pragma("unroll") for (int k = 0; k < 2; ++k) \
        acc[ai][bj][m][n] = __builtin_amdgcn_mfma_f32_16x16x32_bf16(Bt[n][k], At[m][k], acc[ai][bj][m][n], 0, 0, 0); __builtin_amdgcn_s_setprio(0); } while (0)
#define PG8_WAIT_V(n) asm volatile("s_waitcnt vmcnt(" #n ")" ::: "memory")
#define PG8_WAIT_L(n) asm volatile("s_waitcnt lgkmcnt(" #n ")" ::: "memory")
#define PG8_BAR __builtin_amdgcn_s_barrier()
#define PG8_SCHED __builtin_amdgcn_sched_barrier(0)
    Unit cur, nxt; int ui = 0;
    if (!S.next(0, cur)) return;
    f32x4 acc[2][2][4][2];
#pragma unroll
    for (int a = 0; a < 2; ++a)
#pragma unroll
        for (int b = 0; b < 2; ++b)
#pragma unroll
            for (int m = 0; m < 4; ++m)
#pragma unroll
                for (int n = 0; n < 2; ++n) acc[a][b][m][n] = (f32x4){0.f, 0.f, 0.f, 0.f};
    bf16x8 At[4][2], B0[2][2], B1[2][2];
    const char* cA = (const char*)g.A + (size_t)cur.pm * tstepA + (size_t)cur.pn * g.apn; const char* cB = (const char*)g.Bt + (size_t)cur.pn * tstepB;
    PG8_STAGE(PG8_SB(0, 0), cB, voffB); PG8_STAGE(PG8_SA(0, 0), cA, voffA); PG8_STAGE(PG8_SB(0, 1), cB + hstepB, voffB); PG8_STAGE(PG8_SA(0, 1), cA + hstepA, voffA);
    if (wr == 1) PG8_BAR;
    PG8_WAIT_V(4); PG8_BAR;
    PG8_STAGE(PG8_SB(1, 0), cB + kstep, voffB); PG8_STAGE(PG8_SA(1, 0), cA + kstep, voffA); PG8_STAGE(PG8_SB(1, 1), cB + hstepB + kstep, voffB);
    PG8_WAIT_V(6); PG8_BAR;
    for (;;) {
        const bool has_next = S.next(ui + 1, nxt);
        const char* nA = has_next ? (const char*)g.A + (size_t)nxt.pm * tstepA + (size_t)nxt.pn * g.apn : cA; const char* nB = has_next ? (const char*)g.Bt + (size_t)nxt.pn * tstepB : cB;
        for (int t = 0; t < nt; t += 2) {
            const bool last = (t == nt - 2);
            const char* a1 = cA + (size_t)(t + 1) * kstep;
            const char* a2 = last ? nA : cA + (size_t)(t + 2) * kstep; const char* b2 = last ? nB : cB + (size_t)(t + 2) * kstep;
            const char* a3 = a2 + kstep; const char* b3 = b2 + kstep;
            PG8_LDB(B0, 0, 0); PG8_SCHED; PG8_LDA(At, 0, 0); PG8_STAGE(PG8_SA(1, 1), a1 + hstepA, voffA);
            PG8_WAIT_L(8); PG8_BAR; PG8_WAIT_L(0); PG8_MMA(0, 0, At, B0); PG8_BAR; PG8_SCHED;
            PG8_LDB(B1, 0, 1); PG8_STAGE(PG8_SB(0, 0), b2, voffB);
            PG8_BAR; PG8_WAIT_L(0); PG8_MMA(0, 1, At, B1); PG8_BAR;
            PG8_LDA(At, 0, 1); PG8_STAGE(PG8_SA(0, 0), a2, voffA);
            PG8_BAR; PG8_WAIT_L(0); PG8_MMA(1, 0, At, B0); PG8_BAR; PG8_SCHED;
            PG8_STAGE(PG8_SB(0, 1), b2 + hstepB, voffB);
            PG8_WAIT_V(6); PG8_BAR; PG8_MMA(1, 1, At, B1); PG8_BAR;
            PG8_LDB(B0, 1, 0); PG8_SCHED; PG8_LDA(At, 1, 0); PG8_STAGE(PG8_SA(0, 1), a2 + hstepA, voffA);
            PG8_WAIT_L(8); PG8_BAR; PG8_WAIT_L(0); PG8_MMA(0, 0, At, B0); PG8_BAR; PG8_SCHED;
            PG8_LDB(B1, 1, 1); PG8_STAGE(PG8_SB(1, 0), b3, voffB);
            PG8_BAR; PG8_WAIT_L(0); PG8_MMA(0, 1, At, B1); PG8_BAR;
            PG8_LDA(At, 1, 1); PG8_STAGE(PG8_SA(1, 0), a3, voffA);
            PG8_BAR; PG8_WAIT_L(0); PG8_MMA(1, 0, At, B0); PG8_BAR; PG8_SCHED;
            PG8_STAGE(PG8_SB(1, 1), b3 + hstepB, voffB);
            PG8_WAIT_V(6); PG8_BAR; PG8_MMA(1, 1, At, B1); PG8_BAR;
        }
        E(acc, cur, wr, wc, fr, fq);
        if (!has_next) break;
#pragma unroll
        for (int a = 0; a < 2; ++a)
#pragma unroll
            for (int b = 0; b < 2; ++b)
#pragma unroll
                for (int m = 0; m < 4; ++m)
#pragma unroll
                    for (int n = 0; n < 2; ++n) acc[a][b][m][n] = (f32x4){0.f, 0.f, 0.f, 0.f};
        cur = nxt; cA = nA; cB = nB; ++ui;
    }
    PG8_WAIT_V(0);
    if (wr == 0) PG8_BAR;
    PG8_BAR;
#undef PG8_SA
#undef PG8_SB
#undef PG8_STAGE
#undef PG8_LDA
#undef PG8_LDB
#undef PG8_MMA
#undef PG8_WAIT_V
#undef PG8_WAIT_L
#undef PG8_BAR
#undef PG8_SCHED
}
}

enum { E_RES_IN = 0, E_RES_LN = 1, E_SWIGLU = 2, E_GDN = 3, E_RET = 4 };
template <int MODE> struct Epi {
    const float* st_in; const float* c1; const float* c2;
    const float* xp; const float* xs;
    const bf16_t* yprev; const float* lg; const float* lb;
    float* st_out; bf16_t* yout;
    bf16_t* ob; float* of; const float* rope;
    __device__ __forceinline__ void operator()(const f32x4 (&acc)[2][2][4][2], const pg8::Unit& u, int wr, int wc, int fr, int fq) const {
        int fr_ = fr, fq_ = fq; asm volatile("" : "+v"(fr_), "+v"(fq_));
        const int rowb = u.pm * 256 + wr * 64 + fr_;
        const int colb = u.pn * 256 + wc * 32 + 8 * fq_;
#pragma unroll
        for (int hb = 0; hb < 2; ++hb) {
            float mu[4], rstd[4];
            if constexpr (MODE != E_RES_IN) {
                f32x4 sv[4][2];
#pragma unroll
                for (int m = 0; m < 4; ++m) { const f32x4* sp = (const f32x4*)(st_in + 32 * (size_t)(rowb + hb * 128 + m * 16)) + 2 * fq; sv[m][0] = sp[0]; sv[m][1] = sp[1]; }
#pragma unroll
                for (int m = 0; m < 4; ++m) {
                    float s = (sv[m][0].x + sv[m][0].z) + (sv[m][1].x + sv[m][1].z), q = (sv[m][0].y + sv[m][0].w) + (sv[m][1].y + sv[m][1].w);
                    s += __shfl_xor(s, 16); q += __shfl_xor(q, 16); s += __shfl_xor(s, 32); q += __shfl_xor(q, 32);
                    ln_finish(s, q, mu[m], rstd[m]);
                }
                asm volatile("" ::: "memory");
            }
            if constexpr (MODE < 2) {
                float ssum[4], ssq[4];
#pragma unroll
                for (int m = 0; m < 4; ++m) { ssum[m] = 0.f; ssq[m] = 0.f; }
#pragma unroll
                for (int bj = 0; bj < 2; ++bj) {
                    const int c0 = colb + bj * 128;
                    f32x4 g0, g1, b0, b1;
                    if constexpr (MODE == E_RES_LN) { g0 = *(const f32x4*)(lg + c0); g1 = *(const f32x4*)(lg + c0 + 4); b0 = *(const f32x4*)(lb + c0); b1 = *(const f32x4*)(lb + c0 + 4); }
                    constexpr int RB = MODE == E_RES_LN ? 2 : 4;
#pragma unroll
                    for (int m0 = 0; m0 < 4; m0 += RB) {
                        f32x4 xa[MODE == E_RES_IN ? RB : 1], xb[MODE == E_RES_IN ? RB : 1]; u32x4 xw[MODE == E_RES_IN ? 1 : RB];
#pragma unroll
                        for (int mm = 0; mm < RB; ++mm) {
                            const int r = rowb + hb * 128 + (m0 + mm) * 16;
                            if constexpr (MODE == E_RES_IN) {
                                const float* src = (u.pm < MPR / 256 ? xp + (size_t)r * D : xs + (size_t)(r - MPR < NS ? r - MPR : NS - 1) * D);
                                xa[mm] = *(const f32x4*)(src + c0); xb[mm] = *(const f32x4*)(src + c0 + 4);
                            } else xw[mm] = *(const u32x4*)(yprev + (size_t)r * D + c0);
                        }
#pragma unroll
                        for (int mm = 0; mm < RB; ++mm) {
                            const int m = m0 + mm, r = rowb + hb * 128 + m * 16;
                            f32x4 v0, v1;
                            if constexpr (MODE == E_RES_IN) { v0 = xa[mm]; v1 = xb[mm]; }
                            else { const u32x4 w = xw[mm];
                                v0 = (f32x4){bf_lo(w.x), bf_hi(w.x), bf_lo(w.y), bf_hi(w.y)}; v1 = (f32x4){bf_lo(w.z), bf_hi(w.z), bf_lo(w.w), bf_hi(w.w)};
                                v0 = (v0 - mu[m]) * rstd[m] * g0 + b0; v1 = (v1 - mu[m]) * rstd[m] * g1 + b1; }
                            const f32x4 y0 = v0 * DN_ALPHA + acc[hb][bj][m][0], y1 = v1 * DN_ALPHA + acc[hb][bj][m][1];
                            u32x4 o; o.x = cvt_pk_bf16(y0[0], y0[1]); o.y = cvt_pk_bf16(y0[2], y0[3]); o.z = cvt_pk_bf16(y1[0], y1[1]); o.w = cvt_pk_bf16(y1[2], y1[3]);
                            *(u32x4*)(yout + (size_t)r * D + c0) = o;
                            ssum[m] += (y0[0] + y0[1]) + (y0[2] + y0[3]) + (y1[0] + y1[1]) + (y1[2] + y1[3]);
                            ssq[m] += (y0[0] * y0[0] + y0[1] * y0[1]) + (y0[2] * y0[2] + y0[3] * y0[3]) + (y1[0] * y1[0] + y1[1] * y1[1]) + (y1[2] * y1[2] + y1[3] * y1[3]);
                        }
                        asm volatile("" ::: "memory");
                    }
                }
#pragma unroll
                for (int m = 0; m < 4; ++m) {
                    float s = ssum[m], q = ssq[m];
                    s += __shfl_xor(s, 16); s += __shfl_xor(s, 32); q += __shfl_xor(q, 16); q += __shfl_xor(q, 32);
                    if (fq == 0) *(f32x2*)(st_out + 32 * (size_t)(rowb + hb * 128 + m * 16) + 2 * (u.pn * 4 + wc)) = (f32x2){s, q};
                }
            } else {
#pragma unroll
                for (int bj = 0; bj < 2; ++bj) {
                    const int c0 = colb + bj * 128;
                    const f32x4 k10 = *(const f32x4*)(c1 + c0), k11 = *(const f32x4*)(c1 + c0 + 4), k20 = *(const f32x4*)(c2 + c0), k21 = *(const f32x4*)(c2 + c0 + 4);
#pragma unroll
                    for (int m = 0; m < 4; ++m) {
                        const int r = rowb + hb * 128 + m * 16;
                        const f32x4 h0 = (acc[hb][bj][m][0] - k10 * mu[m]) * rstd[m] + k20, h1 = (acc[hb][bj][m][1] - k11 * mu[m]) * rstd[m] + k21;
                        if constexpr (MODE == E_SWIGLU) {
                            u32x2 o; o.x = cvt_pk_bf16(fsilu(h0[0]) * h0[1], fsilu(h0[2]) * h0[3]); o.y = cvt_pk_bf16(fsilu(h1[0]) * h1[1], fsilu(h1[2]) * h1[3]);
                            *(u32x2*)(ob + (size_t)r * DFF + (c0 >> 1)) = o;
                        } else if constexpr (MODE == E_GDN) {
                            if (c0 < 4096) {
                                u32x4 o; o.x = cvt_pk_bf16(h0[0], h0[1]); o.y = cvt_pk_bf16(h0[2], h0[3]); o.z = cvt_pk_bf16(h1[0], h1[1]); o.w = cvt_pk_bf16(h1[2], h1[3]);
                                *(u32x4*)(ob + (size_t)r * 4096 + c0) = o;
                            } else if (c0 < GIN) {
                                *(f32x4*)(of + (size_t)r * 16 + (c0 - 4096)) = h0; *(f32x4*)(of + (size_t)r * 16 + (c0 - 4096) + 4) = h1;
                            }
                        } else {
                            if (u.pn < 8) {
                                const int pidx = r < MPR ? (r & (T - 1)) : T;
                                const int hd = c0 & ~127, i0 = (c0 & 127) >> 1;
                                const f32x4 t0 = *(const f32x4*)(rope + ((size_t)pidx * 64 + i0) * 2), t1 = *(const f32x4*)(rope + ((size_t)pidx * 64 + i0) * 2 + 4);
                                const float sc = c0 >= 1024 ? 0.088388347648318f : 1.0f;
                                const float a0 = (h0[0] * t0[0] - h0[1] * t0[1]) * sc, a1 = (h0[2] * t0[2] - h0[3] * t0[3]) * sc, a2 = (h1[0] * t1[0] - h1[1] * t1[1]) * sc, a3 = (h1[2] * t1[2] - h1[3] * t1[3]) * sc;
                                const float e0 = (h0[0] * t0[1] + h0[1] * t0[0]) * sc, e1 = (h0[2] * t0[3] + h0[3] * t0[2]) * sc, e2 = (h1[0] * t1[1] + h1[1] * t1[0]) * sc, e3 = (h1[2] * t1[3] + h1[3] * t1[2]) * sc;
                                u32x2 o1, o2; o1.x = cvt_pk_bf16(a0, a1); o1.y = cvt_pk_bf16(a2, a3); o2.x = cvt_pk_bf16(e0, e1); o2.y = cvt_pk_bf16(e2, e3);
                                *(u32x2*)(ob + (size_t)r * RIN + hd + i0) = o1; *(u32x2*)(ob + (size_t)r * RIN + hd + 64 + i0) = o2;
                            } else {
                                u32x4 o; o.x = cvt_pk_bf16(h0[0], h0[1]); o.y = cvt_pk_bf16(h0[2], h0[3]); o.z = cvt_pk_bf16(h1[0], h1[1]); o.w = cvt_pk_bf16(h1[2], h1[3]);
                                *(u32x4*)(ob + (size_t)r * RIN + c0) = o;
                            }
                        }
                    }
                    asm volatile("" ::: "memory");
                }
            }
        }
    }
};

template <int MAP  >
__device__ __forceinline__ int map_col(int j) {
    if (MAP == 1) return 2 * (j % DFF) + (j / DFF);
    if (MAP == 2) { if (j < 2048) { const int hb = j & ~127, d = j & 127; return hb + 2 * (d & 63) + (d >> 6); } }
    return j;
}
template <int MAP>
__device__ __forceinline__ void transpose_tile(int tid, LAS float* tile, const float* __restrict__ src, int Nsrc, int K, int k0, int j0, bf16_t* __restrict__ dst,
                                               const float* __restrict__ g, const float* __restrict__ b, float& s1, float& s2, const float* __restrict__ ns = nullptr) {
#pragma unroll
    for (int p = 0; p < 2; ++p) {
        const int idx = tid + p * 512, kk = idx >> 4, j4 = (idx & 15) * 4;
        f32x4 v = (f32x4){0.f, 0.f, 0.f, 0.f};
        if (j0 + j4 < Nsrc) v = *(const f32x4*)(src + (size_t)(k0 + kk) * Nsrc + j0 + j4);
        tile[kk * 65 + j4 + 0] = v[0]; tile[kk * 65 + j4 + 1] = v[1]; tile[kk * 65 + j4 + 2] = v[2]; tile[kk * 65 + j4 + 3] = v[3];
    }
    __syncthreads();
    const int jj = tid >> 3, kc = tid & 7, j = j0 + jj;
    const int n = map_col<MAP>(j);
    const float nsc = ns ? ns[j] : 1.0f;
    unsigned w[4];
#pragma unroll
    for (int e = 0; e < 4; ++e) {
        const int ka = kc * 8 + 2 * e;
        const float v0 = tile[ka * 65 + jj] * nsc, v1 = tile[(ka + 1) * 65 + jj] * nsc;
        float g0 = 1.f, g1 = 1.f;
        if (g) { g0 = g[k0 + ka]; g1 = g[k0 + ka + 1]; }
        w[e] = cvt_pk_bf16(v0 * g0, v1 * g1);
        if (g) { s1 += bf_lo(w[e]) + bf_hi(w[e]); s2 += b[k0 + ka] * v0 + b[k0 + ka + 1] * v1; }
    }
    if (j < Nsrc) { u32x4 o; o.x = w[0]; o.y = w[1]; o.z = w[2]; o.w = w[3]; *(u32x4*)(dst + (size_t)n * K + k0 + kc * 8) = o; }
    __syncthreads();
}
template <int MAP>
__device__ __forceinline__ void fold_strip(int tid, LAS float* tile, const float* __restrict__ src, int Nsrc, int j0, bf16_t* __restrict__ dst,
                                           const float* __restrict__ g, const float* __restrict__ b, float* c1, float* c2) {
    float s1 = 0.f, s2 = 0.f;
    for (int kt = 0; kt < 16; ++kt) transpose_tile<MAP>(tid, tile, src, Nsrc, 1024, kt * 64, j0, dst, g, b, s1, s2);
    s1 += __shfl_xor(s1, 1); s1 += __shfl_xor(s1, 2); s1 += __shfl_xor(s1, 4);
    s2 += __shfl_xor(s2, 1); s2 += __shfl_xor(s2, 2); s2 += __shfl_xor(s2, 4);
    const int j = j0 + (tid >> 3);
    if ((tid & 7) == 0 && j < Nsrc) { const int n = map_col<MAP>(j); c1[n] = s1; c2[n] = s2; }
}

template <int LAYER, int WIN>
__device__ __forceinline__ void stencil_block(const float* __restrict__ xin, const bf16_t* __restrict__ y, LAS const float* mr, const f32x2 g2, const f32x2 b2,
                                              int rb, int t0, int c, bf16_t* __restrict__ apool, float* __restrict__ npool  ) {
    f32x2 x[32 + WIN - 1];
#pragma unroll
    for (int i = 0; i < 32 + WIN - 1; ++i) {
        const int t = t0 - (WIN - 1) + i;
        x[i] = (f32x2){0.f, 0.f};
        if (t >= 0) {
            if constexpr (LAYER == 0) x[i] = *(const f32x2*)(xin + (size_t)(rb + t) * D + c);
            else { const unsigned w = *(const unsigned*)(y + (size_t)(rb + t) * D + c); const float mu = mr[(t - t0 + 15) * 2], rs = mr[(t - t0 + 15) * 2 + 1];
                x[i].x = (bf_lo(w) - mu) * rs * g2.x + b2.x; x[i].y = (bf_hi(w) - mu) * rs * g2.y + b2.y; }
        }
    }
    f32x2 s = (f32x2){0.f, 0.f};
#pragma unroll
    for (int j = 0; j < WIN - 1; ++j) s += x[j];
#pragma unroll
    for (int i = 0; i < 32; ++i) {
        const int t = t0 + i; const f32x2 xv = x[WIN - 1 + i];
        s += xv;
        const float inv = 1.0f / (float)(t + 1 < WIN ? t + 1 : WIN);
        const f32x2 pv = s * inv - xv;
        *(unsigned*)(apool + (size_t)(rb + t) * D + c) = cvt_pk_bf16(pv.x, pv.y);
        if (t >= T - PBUF) *(f32x2*)(npool + (size_t)(t - (T - PBUF)) * D + c) = xv;
        s -= x[i];
    }
}
template <int LAYER>
__device__ void pool_stencil_phase(const Ctx& p, LAS unsigned char* lds, int li  , const bf16_t* y, const float* st, const float* lg, const float* lb, bf16_t* apool) {
    const int tid = opaque_tid(), c = tid * 2;
    const int win = 2 << (c >> 8);
    LAS float* mr = (LAS float*)lds;
    f32x2 g2 = (f32x2){1.f, 1.f}, b2 = (f32x2){0.f, 0.f};
    if constexpr (LAYER != 0) { g2 = *(const f32x2*)(lg + c); b2 = *(const f32x2*)(lb + c); }
    const float* xp = p.in(0);
    float* out = p.out();
    for (int item = blockIdx.x; item < NB * 64; item += gridDim.x) {
        const int b = item >> 6, t0 = (item & 63) * 32, rb = b * T;
        if constexpr (LAYER != 0) {
            __syncthreads();
            if (tid < 47 && t0 - 15 + tid >= 0) { float mu, rs; ln_stats(st, rb + t0 - 15 + tid, mu, rs); mr[tid * 2] = mu; mr[tid * 2 + 1] = rs; }
            __syncthreads();
        }
        float* npool = out + O_PP + (size_t)(li * NB + b) * PBUF * D;
        if (win == 2) stencil_block<LAYER, 2>(xp, y, mr, g2, b2, rb, t0, c, apool, npool);
        else if (win == 4) stencil_block<LAYER, 4>(xp, y, mr, g2, b2, rb, t0, c, apool, npool);
        else if (win == 8) stencil_block<LAYER, 8>(xp, y, mr, g2, b2, rb, t0, c, apool, npool);
        else stencil_block<LAYER, 16>(xp, y, mr, g2, b2, rb, t0, c, apool, npool);
    }
    const float* spool = p.in(2) + (size_t)li * NS * PBUF * D;
    for (int i = blockIdx.x; i < NS; i += gridDim.x) {
        f32x2 bufv[PBUF];
#pragma unroll
        for (int q = 0; q < PBUF; ++q) bufv[q] = *(const f32x2*)(spool + ((size_t)i * PBUF + q) * D + c);
        f32x2 xv;
        if constexpr (LAYER == 0) xv = *(const f32x2*)(p.in(1) + (size_t)i * D + c);
        else { float mu, rs; ln_stats(st, MPR + i, mu, rs); const unsigned w = *(const unsigned*)(y + (size_t)(MPR + i) * D + c); xv.x = (bf_lo(w) - mu) * rs * g2.x + b2.x; xv.y = (bf_hi(w) - mu) * rs * g2.y + b2.y; }
        f32x2 s = xv;
#pragma unroll
        for (int j = 1; j < 16; ++j) if (j < win) s += bufv[PBUF - j];
        const f32x2 pv = s * (1.0f / (float)win) - xv;
        *(unsigned*)(apool + (size_t)(MPR + i) * D + c) = cvt_pk_bf16(pv.x, pv.y);
        float* dst = out + O_PS + ((size_t)(li * NS + i) * PBUF) * D + c;
#pragma unroll
        for (int q = 0; q < PBUF - 1; ++q) *(f32x2*)(dst + (size_t)q * D) = bufv[q + 1];
        *(f32x2*)(dst + (size_t)(PBUF - 1) * D) = xv;
    }
}

__device__ __forceinline__ void weight_prep(const Ctx& p, LAS unsigned char* lds, int tid, int stage, int wg, int nwg) {
    LAS float* tile = (LAS float*)lds;
    unsigned char* ws = p.ws();
    float* c1 = (float*)(ws + WS_C1); float* c2 = (float*)(ws + WS_C2);
    const float* ln_g = p.in(18); const float* ln_b = p.in(19);
    float d1 = 0.f, d2 = 0.f;
    const int nstrip = stage == 0 ? 88 + 65 : (stage == 1 ? 88 + 96 : 176);
    for (int t = wg; t < nstrip; t += nwg) {
        if (stage == 0 && t >= 88) { fold_strip<0>(tid, tile, p.in(8), GIN, (t - 88) * 64, (bf16_t*)(ws + WS_WGI), ln_g + 1 * D, ln_b + 1 * D, c1 + 4 * 5632, c2 + 4 * 5632); }
        else if (stage == 1 && t >= 88) { fold_strip<2>(tid, tile, p.in(14), RIN, (t - 88) * 64, (bf16_t*)(ws + WS_WRI), ln_g + 3 * D, ln_b + 3 * D, c1 + 4 * 5632 + GINP, c2 + 4 * 5632 + GINP); }
        else { const int mi = stage == 2 ? 2 + t / 88 : stage, jt = t % 88;
            fold_strip<1>(tid, tile, p.in(16) + (size_t)mi * 1024 * 5632, 5632, jt * 64, (bf16_t*)(ws + WS_W13) + (size_t)mi * 5632 * 1024, ln_g + (size_t)(mi * 2) * D, ln_b + (size_t)(mi * 2) * D, c1 + mi * 5632, c2 + mi * 5632); }
    }
    const int nw2 = stage == 2 ? 1408 : 704, ntile = nw2 + (stage == 0 ? 64 + 256 : (stage == 1 ? 512 : 64));
    for (int t = (wg + nwg - nstrip % nwg) % nwg; t < ntile; t += nwg) {
        const float* src; bf16_t* dst; int Nsrc, K, kt, jt; const float* ns = nullptr;
        if (t < nw2) { const int mi = (stage == 2 ? 2 : stage) + t / 704, tt = t % 704; kt = tt / 16; jt = tt % 16; src = p.in(17) + (size_t)mi * 2816 * 1024; dst = (bf16_t*)(ws + WS_W2) + (size_t)mi * 1024 * 2816; Nsrc = 1024; K = 2816; }
        else { const int u = t - nw2;
            if (stage == 1) { kt = u / 16; jt = u % 16; src = p.in(15); dst = (bf16_t*)(ws + WS_WRO); Nsrc = 1024; K = 2048; }
            else if (u < 64) { const int mi = (stage == 2 ? 4 : 0) + (u >> 4), tt = u & 15; kt = tt >> 2; jt = tt & 3; src = p.in(6) + (size_t)mi * 65536; dst = (bf16_t*)(ws + WS_WPOOL) + (size_t)mi * 65536; Nsrc = 256; K = 256; ns = p.in(7) + (size_t)mi * 256; }
            else { const int v = u - 64; kt = v / 16; jt = v % 16; src = p.in(13); dst = (bf16_t*)(ws + WS_WGO); Nsrc = 1024; K = 1024; } }
        transpose_tile<0>(tid, tile, src, Nsrc, K, kt * 64, jt * 64, dst, nullptr, nullptr, d1, d2, ns);
    }
}

__device__ void prep_phase(const Ctx& p, LAS unsigned char* lds) {
    unsigned char* ws = p.ws();
    const int G = gridDim.x, bid = blockIdx.x, tid = opaque_tid();
    weight_prep(p, lds, tid, 0, bid, G);
    for (size_t i = (size_t)bid * 512 + tid; i < (size_t)(GINP - GIN) * 1024 / 8; i += (size_t)G * 512) ((u32x4*)((bf16_t*)(ws + WS_WGI) + (size_t)GIN * 1024))[i] = (u32x4){0u, 0u, 0u, 0u};
    float* rope = (float*)(ws + WS_ROPE);
    for (int e = bid * 512 + tid; e < 2049 * 64; e += G * 512) {
        const int i = e & 63, pi = e >> 6; const double pos = pi < T ? (double)pi : 16384.0;
        const double freq = exp(-(double)i * (9.210340371976184 / 64.0));
        const double rev = pos * freq * 0.15915494309189535; const float fr = (float)(rev - floor(rev));
        rope[2 * e] = __builtin_amdgcn_cosf(fr); rope[2 * e + 1] = __builtin_amdgcn_sinf(fr);
    }
    pool_stencil_phase<0>(p, lds, 0, nullptr, nullptr, nullptr, nullptr, (bf16_t*)(ws + WS_O));
}

typedef short s16x4 __attribute__((ext_vector_type(4)));
typedef __bf16 bf16v2 __attribute__((ext_vector_type(2)));
__device__ __forceinline__ unsigned pkbf(float lo, float hi) { bf16v2 v = {(__bf16)lo, (__bf16)hi}; return __builtin_bit_cast(unsigned, v); }
#define MFMA16(a, b, c) __builtin_amdgcn_mfma_f32_16x16x32_bf16((a), (b), (c), 0, 0, 0)
__device__ __forceinline__ bf16x8 tr_frag(LAS const unsigned char* img, int pitch, int k0, int c0, int lane) {
    const int i16 = lane & 15;
    LAS const unsigned char* a = img + (k0 + 8 * (lane >> 4) + (i16 >> 2)) * pitch + (c0 + 4 * (i16 & 3)) * 2;
    const s16x4 lo = __builtin_amdgcn_ds_read_tr16_b64_v4i16((LAS s16x4*)a);
    const s16x4 hi = __builtin_amdgcn_ds_read_tr16_b64_v4i16((LAS s16x4*)(a + 4 * pitch));
    return __builtin_shufflevector(lo, hi, 0, 1, 2, 3, 4, 5, 6, 7);
}
__device__ __forceinline__ bf16x8 row_frag(LAS const unsigned char* img, int pitch, int r0, int k0, int lane) {
    return *(LAS const bf16x8*)(img + (r0 + (lane & 15)) * pitch + (k0 + 8 * (lane >> 4)) * 2);
}
__device__ __forceinline__ bf16x8 row_frag_perm(LAS const unsigned char* img, int pitch, int r0, int k0, int lane) {
    LAS const unsigned char* a = img + (r0 + (lane & 15)) * pitch + (k0 + 4 * (lane >> 4)) * 2;
    const s16x4 lo = *(LAS const s16x4*)a, hi = *(LAS const s16x4*)(a + 32);
    return __builtin_shufflevector(lo, hi, 0, 1, 2, 3, 4, 5, 6, 7);
}
__device__ __forceinline__ bf16x8 pack_acc_pair(const f32x4& x, const f32x4& y) {
    u32x4 w; w.x = pkbf(x[0], x[1]); w.y = pkbf(x[2], x[3]); w.z = pkbf(y[0], y[1]); w.w = pkbf(y[2], y[3]);
    return __builtin_bit_cast(bf16x8, w);
}


__device__ void gdn_phase_a(const Ctx& p, LAS unsigned char* lds) {
    constexpr int PQ = 272, PX = 144, LP = 68;
    unsigned char* ws = p.ws();
    const bf16_t* PROJ = (const bf16_t*)(ws + WS_BIG); const float* PROJS = (const float*)(ws + WS_PROJS);
    bf16_t* GWK = (bf16_t*)(ws + WS_GWK); bf16_t* GQG = (bf16_t*)(ws + WS_GQG); bf16_t* GKG = (bf16_t*)(ws + WS_GKG); bf16_t* GU = (bf16_t*)(ws + WS_GU);
    bf16_t* GAT = (bf16_t*)(ws + WS_GAT); float* GGL = (float*)(ws + WS_GGL);
    LAS unsigned char* Kr = lds; LAS unsigned char* Qr = Kr + 64 * PQ; LAS unsigned char* VB = Qr + 64 * PQ; LAS unsigned char* KE = VB + 64 * PQ;
    LAS float* Lf = (LAS float*)(KE + 64 * PQ); LAS unsigned char* Xr = (LAS unsigned char*)(Lf + 64 * LP);
    LAS float* cw = (LAS float*)(Xr + 64 * PX); LAS float* gcs = cw + 4 * 384; LAS float* bet = gcs + 64;
    const int tid = opaque_tid(), lane = tid & 63, wid = __builtin_amdgcn_readfirstlane(tid >> 6), kg = lane >> 4, l15 = lane & 15;
    const int lrow = tid >> 3, lseg = tid & 7;
    const float* convw = p.in(9);
    for (int grp = blockIdx.x; grp < 256; grp += gridDim.x) {
        const int bh = grp >> 2, b = bh >> 3, h = bh & 7;
        __syncthreads();
        for (int i = tid; i < 4 * 384; i += 512) { const int j = i / 384, ch = i - j * 384; cw[i] = convw[j * CCH + (ch >> 7) * 1024 + h * 128 + (ch & 127)]; }
        const float Aneg = -__expf(p.in(10)[h]), dtb = p.in(11)[h];
        for (int e = 0; e < 8; ++e) {
            const int n = (grp & 3) * 8 + e, item = bh * 32 + n, row0 = b * T + n * 64, tseq = n * 64 + lrow;
            float xv[3][16];
            __syncthreads();
#pragma unroll
            for (int part = 0; part < 3; ++part)
#pragma unroll
                for (int gs = 0; gs < 2; ++gs) {
                    const int ch0 = lseg * 16 + gs * 8, gcol = part * 1024 + h * 128 + ch0;
                    float a[8];
#pragma unroll
                    for (int q = 0; q < 8; ++q) a[q] = 0.f;
#pragma unroll
                    for (int j = 0; j < 4; ++j) {
                        if (tseq - 3 + j >= 0) {
                            const u32x4 x = *(const u32x4*)(PROJ + (size_t)(row0 + lrow - 3 + j) * 4096 + gcol);
                            const f32x4 w0 = *(LAS const f32x4*)(cw + j * 384 + part * 128 + ch0), w1 = *(LAS const f32x4*)(cw + j * 384 + part * 128 + ch0 + 4);
                            a[0] += w0[0] * bf_lo(x.x); a[1] += w0[1] * bf_hi(x.x); a[2] += w0[2] * bf_lo(x.y); a[3] += w0[3] * bf_hi(x.y);
                            a[4] += w1[0] * bf_lo(x.z); a[5] += w1[1] * bf_hi(x.z); a[6] += w1[2] * bf_lo(x.w); a[7] += w1[3] * bf_hi(x.w);
                        }
                    }
#pragma unroll
                    for (int q = 0; q < 8; ++q) xv[part][gs * 8 + q] = fsilu(a[q]);
                }
            float sq = 0.f, sk = 0.f;
#pragma unroll
            for (int q = 0; q < 16; ++q) { sq += xv[0][q] * xv[0][q]; sk += xv[1][q] * xv[1][q]; }
            sq += __shfl_xor(sq, 1); sq += __shfl_xor(sq, 2); sq += __shfl_xor(sq, 4); sk += __shfl_xor(sk, 1); sk += __shfl_xor(sk, 2); sk += __shfl_xor(sk, 4);
            const float qn = rsqrtf(sq + RMS_EPS) * 0.088388347648318f, kn = rsqrtf(sk + RMS_EPS);
            if (wid == 0) {
                const size_t r2 = (size_t)(row0 + lane);
                const float x = PROJS[r2 * 16 + 8 + h] + dtb; const float sp = x > 20.f ? x : log1pf(__expf(x));
                float g = Aneg * sp;
#pragma unroll
                for (int o = 1; o < 64; o <<= 1) { const float t = __shfl_up(g, o); if (lane >= o) g += t; }
                gcs[lane] = g; bet[lane] = fsigmoid(PROJS[r2 * 16 + h]);
            }
            __syncthreads();
            {
                const float gcr = gcs[lrow], gcl = gcs[63], br = bet[lrow];
                const float eg = __expf(gcr), egl = __expf(gcl - gcr);
                if (tid == 0) GGL[item] = __expf(gcl);
#pragma unroll
                for (int gs = 0; gs < 2; ++gs) {
                    u32x4 wq, wk_, wv, we, wqg, wkg;
                    unsigned* pq = (unsigned*)&wq; unsigned* pk = (unsigned*)&wk_; unsigned* pv = (unsigned*)&wv; unsigned* pe = (unsigned*)&we; unsigned* pqg = (unsigned*)&wqg; unsigned* pkg = (unsigned*)&wkg;
#pragma unroll
                    for (int q2 = 0; q2 < 4; ++q2) {
                        const float q0 = xv[0][gs * 8 + 2 * q2] * qn, q1 = xv[0][gs * 8 + 2 * q2 + 1] * qn, k0 = xv[1][gs * 8 + 2 * q2] * kn, k1 = xv[1][gs * 8 + 2 * q2 + 1] * kn;
                        const float v0 = xv[2][gs * 8 + 2 * q2], v1 = xv[2][gs * 8 + 2 * q2 + 1];
                        pq[q2] = pkbf(q0, q1); pk[q2] = pkbf(k0, k1); pv[q2] = pkbf(v0 * br, v1 * br); pe[q2] = pkbf(k0 * br * eg, k1 * br * eg);
                        pqg[q2] = pkbf(q0 * eg, q1 * eg); pkg[q2] = pkbf(k0 * egl, k1 * egl);
                    }
                    const int off = lrow * PQ + (lseg * 16 + gs * 8) * 2;
                    *(LAS u32x4*)(Qr + off) = wq; *(LAS u32x4*)(Kr + off) = wk_; *(LAS u32x4*)(VB + off) = wv; *(LAS u32x4*)(KE + off) = we;
                    const size_t go = ((size_t)item * 64 + lrow) * 128 + lseg * 16 + gs * 8;
                    *(u32x4*)(GQG + go) = wqg; *(u32x4*)(GKG + go) = wkg;
                }
            }
            __syncthreads();
            for (int u = wid; u < 16; u += 8) {
                const int it = u >> 2, jt = u & 3, i = it * 16 + l15, j0 = jt * 16 + 4 * kg;
                u32x2 ao = (u32x2){0u, 0u};
                if (jt <= it) {
                    f32x4 kk = (f32x4){0.f, 0.f, 0.f, 0.f}, qk = kk;
#pragma unroll
                    for (int ks = 0; ks < 4; ++ks) { const bf16x8 a = row_frag(Kr, PQ, jt * 16, ks * 32, lane);
                        kk = MFMA16(a, row_frag(Kr, PQ, it * 16, ks * 32, lane), kk); qk = MFMA16(a, row_frag(Qr, PQ, it * 16, ks * 32, lane), qk); }
                    const float gi = gcs[i], bi = bet[i];
                    float lv[4], av[4];
#pragma unroll
                    for (int r = 0; r < 4; ++r) { const int j = j0 + r; const float dec = i >= j ? __expf(gi - gcs[j]) : 0.f; lv[r] = i > j ? bi * kk[r] * dec : 0.f; av[r] = qk[r] * dec; }
                    *(LAS f32x4*)(Lf + i * LP + j0) = (f32x4){lv[0], lv[1], lv[2], lv[3]};
                    ao.x = pkbf(av[0], av[1]); ao.y = pkbf(av[2], av[3]);
                }
                *(u32x2*)(GAT + ((size_t)item * 64 + i) * 64 + j0) = ao;
            }
            __syncthreads();
            if (wid == 0) {
                float x[64];
                int ln = lane; asm volatile("" : "+v"(ln));
                LAS const float* Lb = Lf; asm volatile("" : "+v"(Lb));
                LAS unsigned char* Xb = Xr + ln * 2; asm volatile("" : "+v"(Xb));
#pragma unroll
                for (int i = 0; i < 64; ++i) x[i] = 0.f;
#pragma unroll
                for (int i = 0; i < 64; ++i) {
                    float a0 = ln == i ? 1.f : 0.f, a1 = 0.f;
#pragma unroll
                    for (int j4 = 0; j4 < (i + 3) / 4; ++j4) { const f32x4 l = *(LAS const f32x4*)(Lb + i * LP + 4 * j4);
                        a0 -= l[0] * x[4 * j4]; a1 -= l[1] * x[4 * j4 + 1]; a0 -= l[2] * x[4 * j4 + 2]; a1 -= l[3] * x[4 * j4 + 3]; }
                    x[i] = a0 + a1;
                    *(LAS bf16_t*)(Xb + i * PX) = (bf16_t)(pkbf(x[i], 0.f) & 0xffffu);
                }
            }
            __syncthreads();
            for (int t8 = 0; t8 < 8; ++t8) {
                const int tile = wid + 8 * t8, kind = tile >> 5, ct = (tile >> 2) & 7, it = tile & 3;
                f32x4 acc = (f32x4){0.f, 0.f, 0.f, 0.f};
#pragma unroll
                for (int ks = 0; ks < 2; ++ks) acc = MFMA16(tr_frag(kind ? KE : VB, PQ, ks * 32, ct * 16, lane), row_frag(Xr, PX, it * 16, ks * 32, lane), acc);
                u32x2 o; o.x = pkbf(acc[0], acc[1]); o.y = pkbf(acc[2], acc[3]);
                *(u32x2*)((kind ? GWK : GU) + ((size_t)item * 64 + it * 16 + l15) * 128 + ct * 16 + 4 * kg) = o;
            }
        }
    }
}

__device__ void gdn_phase_b(const Ctx& p, LAS unsigned char* lds) {
    constexpr int PQ = 272, PA = 144;
    unsigned char* ws = p.ws();
    const bf16_t* PROJ = (const bf16_t*)(ws + WS_BIG); const float* PROJS = (const float*)(ws + WS_PROJS); bf16_t* O = (bf16_t*)(ws + WS_O);
    const int tid = opaque_tid(), lane = tid & 63, wid = __builtin_amdgcn_readfirstlane(tid >> 6), kg = lane >> 4, l15 = lane & 15;
    const int G = gridDim.x, bid = blockIdx.x;
    const float* norm_g = p.in(12);
    const int n_prompt = (G > 64) ? 64 : 0;
    if (bid < n_prompt) {
        const bf16_t* GWK = (const bf16_t*)(ws + WS_GWK); const bf16_t* GQG = (const bf16_t*)(ws + WS_GQG); const bf16_t* GKG = (const bf16_t*)(ws + WS_GKG); const bf16_t* GU = (const bf16_t*)(ws + WS_GU);
        const bf16_t* GAT = (const bf16_t*)(ws + WS_GAT); const float* GGL = (const float*)(ws + WS_GGL);
        LAS unsigned char* Wk = lds; LAS unsigned char* Qg = Wk + 64 * PQ; LAS unsigned char* Kg = Qg + 64 * PQ; LAS unsigned char* Vn = Kg + 64 * PQ; LAS unsigned char* At = Vn + 64 * PQ;
        LAS float* part = (LAS float*)(At + 64 * PA);
        const int b = bid >> 3, h = bid & 7, lrow = tid >> 3, lseg = tid & 7;
        f32x4 S[8];
#pragma unroll
        for (int dt = 0; dt < 8; ++dt) S[dt] = (f32x4){0.f, 0.f, 0.f, 0.f};
        const f32x4 ng = *(const f32x4*)(norm_g + wid * 16 + 4 * kg);
        u32x4 rw[2], rqg[2], rkg[2], rat; u32x2 ru[4], rz[4]; float gl;
#define GDN_LOAD(n) do { const size_t it_ = (size_t)(bid * 32 + (n)); const size_t go_ = (it_ * 64 + lrow) * 128 + lseg * 16; \
            rw[0] = *(const u32x4*)(GWK + go_); rw[1] = *(const u32x4*)(GWK + go_ + 8); rqg[0] = *(const u32x4*)(GQG + go_); rqg[1] = *(const u32x4*)(GQG + go_ + 8); \
            rkg[0] = *(const u32x4*)(GKG + go_); rkg[1] = *(const u32x4*)(GKG + go_ + 8); rat = *(const u32x4*)(GAT + (it_ * 64 + lrow) * 64 + lseg * 8); gl = GGL[it_]; \
            _Pragma("unroll") for (int it2 = 0; it2 < 4; ++it2) { ru[it2] = *(const u32x2*)(GU + (it_ * 64 + it2 * 16 + l15) * 128 + wid * 16 + 4 * kg); \
                rz[it2] = *(const u32x2*)(PROJ + (size_t)(b * T + (n) * 64 + it2 * 16 + l15) * 4096 + 3072 + h * 128 + wid * 16 + 4 * kg); } } while (0)
        GDN_LOAD(0);
        for (int n = 0; n < T / 64; ++n) {
            __syncthreads();
#pragma unroll
            for (int e = 0; e < 2; ++e) { const int off = lrow * PQ + (lseg * 16 + e * 8) * 2; *(LAS u32x4*)(Wk + off) = rw[e]; *(LAS u32x4*)(Qg + off) = rqg[e]; *(LAS u32x4*)(Kg + off) = rkg[e]; }
            *(LAS u32x4*)(At + lrow * PA + lseg * 16) = rat;
            u32x2 cu[4], cz[4]; const float cgl = gl;
#pragma unroll
            for (int it = 0; it < 4; ++it) { cu[it] = ru[it]; cz[it] = rz[it]; }
            __syncthreads();
            if (n + 1 < T / 64) GDN_LOAD(n + 1);
            bf16x8 sp[4];
#pragma unroll
            for (int s4 = 0; s4 < 4; ++s4) sp[s4] = pack_acc_pair(S[2 * s4], S[2 * s4 + 1]);
#pragma unroll
            for (int it = 0; it < 4; ++it) {
                f32x4 pacc = (f32x4){0.f, 0.f, 0.f, 0.f};
#pragma unroll
                for (int s4 = 0; s4 < 4; ++s4) pacc = MFMA16(sp[s4], row_frag_perm(Wk, PQ, it * 16, s4 * 32, lane), pacc);
                const float v0 = bf_lo(cu[it].x) - pacc[0], v1 = bf_hi(cu[it].x) - pacc[1], v2 = bf_lo(cu[it].y) - pacc[2], v3 = bf_hi(cu[it].y) - pacc[3];
                u32x2 w; w.x = pkbf(v0, v1); w.y = pkbf(v2, v3);
                *(LAS u32x2*)(Vn + (it * 16 + l15) * PQ + (wid * 16 + 4 * kg) * 2) = w;
            }
            f32x4 oacc[4];
#pragma unroll
            for (int it = 0; it < 4; ++it) { oacc[it] = (f32x4){0.f, 0.f, 0.f, 0.f};
#pragma unroll
                for (int s4 = 0; s4 < 4; ++s4) oacc[it] = MFMA16(sp[s4], row_frag_perm(Qg, PQ, it * 16, s4 * 32, lane), oacc[it]); }
            bf16x8 vf[2];
#pragma unroll
            for (int ks = 0; ks < 2; ++ks) vf[ks] = tr_frag(Vn, PQ, ks * 32, wid * 16, lane);
#pragma unroll
            for (int it = 0; it < 4; ++it)
#pragma unroll
                for (int ks = 0; ks < 2; ++ks) if (ks == 0 || it >= 2) oacc[it] = MFMA16(vf[ks], row_frag(At, PA, it * 16, ks * 32, lane), oacc[it]);
#pragma unroll
            for (int dt = 0; dt < 8; ++dt) { S[dt] *= cgl;
#pragma unroll
                for (int ks = 0; ks < 2; ++ks) S[dt] = MFMA16(tr_frag(Kg, PQ, ks * 32, dt * 16, lane), vf[ks], S[dt]); }
#pragma unroll
            for (int it = 0; it < 4; ++it) {
                float sq = oacc[it][0] * oacc[it][0] + oacc[it][1] * oacc[it][1] + oacc[it][2] * oacc[it][2] + oacc[it][3] * oacc[it][3];
                sq += __shfl_xor(sq, 16); sq += __shfl_xor(sq, 32);
                if (kg == 0) part[(it * 16 + l15) * 8 + wid] = sq;
            }
            __syncthreads();
#pragma unroll
            for (int it = 0; it < 4; ++it) {
                const f32x4 p0 = *(LAS const f32x4*)(part + (it * 16 + l15) * 8), p1 = *(LAS const f32x4*)(part + (it * 16 + l15) * 8 + 4);
                const float rn = rsqrtf(((p0[0] + p0[1]) + (p0[2] + p0[3]) + (p1[0] + p1[1]) + (p1[2] + p1[3])) * (1.0f / 128.0f) + RMS_EPS);
                const f32x4 o = oacc[it] * rn * ng;
                u32x2 w; w.x = pkbf(o[0] * fsilu(bf_lo(cz[it].x)), o[1] * fsilu(bf_hi(cz[it].x))); w.y = pkbf(o[2] * fsilu(bf_lo(cz[it].y)), o[3] * fsilu(bf_hi(cz[it].y)));
                *(u32x2*)(O + (size_t)(b * T + n * 64 + it * 16 + l15) * D + h * 128 + wid * 16 + 4 * kg) = w;
            }
        }
#undef GDN_LOAD
        float* dst = p.out() + O_GP + (size_t)(b * 8 + h) * 128 * 128;
#pragma unroll
        for (int dt = 0; dt < 8; ++dt)
#pragma unroll
            for (int r = 0; r < 4; ++r) dst[(size_t)(dt * 16 + 4 * kg + r) * 128 + wid * 16 + l15] = S[dt][r];
    } else {
        LAS float* qs = (LAS float*)lds; LAS float* ks = qs + 128; LAS float* vs = ks + 128; LAS float* sc = vs + 128; LAS float* red = sc + 16;
        const int c4 = (tid & 31) * 4, grp = tid >> 5, d0 = grp * 8;
        const float* convw = p.in(9); const float* sconv = p.in(3);
        for (int it = bid - n_prompt; it < NS * 8; it += G - n_prompt) {
            const int h = it & 7, sq = it >> 3, r = MPR + sq;
            const f32x4* s0 = (const f32x4*)(p.in(4) + ((size_t)(sq * 8 + h) * 128 + d0) * 128 + c4);
            f32x4 Sv[8];
#pragma unroll
            for (int dd = 0; dd < 8; ++dd) Sv[dd] = s0[(size_t)dd * 32];
            if (tid < 384) {
                const int part = tid >> 7, dd = tid & 127, gch = part * 1024 + h * 128 + dd;
                float a = convw[3 * CCH + gch] * bf2f(PROJ[(size_t)r * 4096 + gch]);
#pragma unroll
                for (int j = 0; j < 3; ++j) a += convw[j * CCH + gch] * sconv[((size_t)sq * 3 + j) * CCH + gch];
                (part == 0 ? qs : (part == 1 ? ks : vs))[dd] = fsilu(a);
            }
            if (tid == 0) { const float x = PROJS[(size_t)r * 16 + 8 + h] + p.in(11)[h]; const float sp = x > 20.f ? x : log1pf(__expf(x));
                sc[0] = fsigmoid(PROJS[(size_t)r * 16 + h]); sc[1] = __expf(-__expf(p.in(10)[h]) * sp); }
            __syncthreads();
            if (wid == 0) {
                float q0 = qs[lane], q1 = qs[64 + lane], k0 = ks[lane], k1 = ks[64 + lane];
                const float qn = rsqrtf(wave_sum(q0 * q0 + q1 * q1) + RMS_EPS) * 0.088388347648318f, kn = rsqrtf(wave_sum(k0 * k0 + k1 * k1) + RMS_EPS);
                q0 *= qn; q1 *= qn; k0 *= kn; k1 *= kn;
                qs[lane] = q0; qs[64 + lane] = q1; ks[lane] = k0; ks[64 + lane] = k1;
                const float dt = wave_sum(q0 * k0 + q1 * k1);
                if (lane == 0) sc[2] = dt;
            }
            __syncthreads();
            f32x4 rp = (f32x4){0.f, 0.f, 0.f, 0.f}, pp = rp;
#pragma unroll
            for (int dd = 0; dd < 8; ++dd) { rp += Sv[dd] * ks[d0 + dd]; pp += Sv[dd] * qs[d0 + dd]; }
            *(LAS f32x4*)(red + grp * 128 + c4) = rp; *(LAS f32x4*)(red + 2048 + grp * 128 + c4) = pp;
            __syncthreads();
            rp = (f32x4){0.f, 0.f, 0.f, 0.f}; pp = rp;
#pragma unroll
            for (int g2 = 0; g2 < 16; ++g2) { rp += *(LAS const f32x4*)(red + g2 * 128 + c4); pp += *(LAS const f32x4*)(red + 2048 + g2 * 128 + c4); }
            const float beta = sc[0], a = sc[1], qk = sc[2];
            const f32x4 vnew = (*(LAS const f32x4*)(vs + c4) - rp * a) * beta;
            f32x4* dst = (f32x4*)(p.out() + O_GS + ((size_t)(sq * 8 + h) * 128 + d0) * 128 + c4);
#pragma unroll
            for (int dd = 0; dd < 8; ++dd) dst[(size_t)dd * 32] = Sv[dd] * a + vnew * ks[d0 + dd];
            if (tid < 32) {
                const f32x4 o = pp * a + vnew * qk;
                float ss = (o[0] * o[0] + o[1] * o[1]) + (o[2] * o[2] + o[3] * o[3]);
#pragma unroll
                for (int x = 16; x >= 1; x >>= 1) ss += __shfl_xor(ss, x);
                const float rn = rsqrtf(ss * (1.0f / 128.0f) + RMS_EPS);
                const u32x2 zw = *(const u32x2*)(PROJ + (size_t)r * 4096 + 3072 + h * 128 + c4);
                const f32x4 ng4 = *(const f32x4*)(norm_g + c4);
                u32x2 w; w.x = pkbf(o[0] * rn * ng4[0] * fsilu(bf_lo(zw.x)), o[1] * rn * ng4[1] * fsilu(bf_hi(zw.x))); w.y = pkbf(o[2] * rn * ng4[2] * fsilu(bf_lo(zw.y)), o[3] * rn * ng4[3] * fsilu(bf_hi(zw.y)));
                *(u32x2*)(O + (size_t)r * D + h * 128 + c4) = w;
            }
            __syncthreads();
        }
        weight_prep(p, lds, tid, 1, bid - n_prompt, G - n_prompt);
    }
    const float* sconv2 = p.in(3);
    for (int idx = bid * 512 + tid; idx < NB * 3 * CCH; idx += G * 512) { const int b2 = idx / (3 * CCH), j = (idx / CCH) % 3, ch = idx % CCH;
        p.out()[O_CP + idx] = bf2f(PROJ[(size_t)(b2 * T + T - 3 + j) * 4096 + ch]); }
    for (int idx = bid * 512 + tid; idx < NS * 3 * CCH; idx += G * 512) { const int i = idx / (3 * CCH), j = (idx / CCH) % 3, ch = idx % CCH;
        p.out()[O_CS + idx] = j < 2 ? sconv2[((size_t)i * 3 + j + 1) * CCH + ch] : bf2f(PROJ[(size_t)(MPR + i) * 4096 + ch]); }
}

__device__ void ret_scan_phase(const Ctx& p, LAS unsigned char* lds) {
    constexpr int PQ = 272, PV = 528, PA = 144;
    unsigned char* ws = p.ws();
    const bf16_t* PR = (const bf16_t*)(ws + WS_BIG); bf16_t* O2 = (bf16_t*)(ws + WS_O);
    const int tid = opaque_tid(), lane = tid & 63, wid = __builtin_amdgcn_readfirstlane(tid >> 6), kg = lane >> 4, l15 = lane & 15;
    const int G = gridDim.x, bid = blockIdx.x;
    const int n_prompt = (G > 64) ? 64 : 0;
    if (bid < n_prompt) {
        LAS unsigned char* Qs = lds; LAS unsigned char* Ks = Qs + 64 * PQ; LAS unsigned char* Kz = Ks + 64 * PQ; LAS unsigned char* Vs = Kz + 64 * PQ; LAS unsigned char* At = Vs + 64 * PV;
        LAS float* part = (LAS float*)(At + 64 * PA); LAS float* pw = part + 64 * 8 * 2;
        const int b = bid >> 3, h = bid & 7;
        const float lg2 = log2f(1.0f - exp2f(-5.0f - (float)h));
        if (tid <= 64) pw[tid] = exp2f((float)tid * lg2);
        for (int i = tid; i < 64 * PA / 4; i += 512) ((LAS unsigned*)At)[i] = 0u;
        f32x4 S[8][2];
#pragma unroll
        for (int dt = 0; dt < 8; ++dt) { S[dt][0] = (f32x4){0.f, 0.f, 0.f, 0.f}; S[dt][1] = S[dt][0]; }
        const int lrow = tid >> 3, lseg = tid & 7;
        u32x4 rq[2], rk[2], rv[4];
        const bf16_t* gsrc = PR + (size_t)(b * T + lrow) * RIN;
#define RET_LOAD(n) do { const bf16_t* g_ = gsrc + (size_t)(n) * 64 * RIN; \
            rq[0] = *(const u32x4*)(g_ + h * 128 + lseg * 16); rq[1] = *(const u32x4*)(g_ + h * 128 + lseg * 16 + 8); \
            rk[0] = *(const u32x4*)(g_ + 1024 + h * 128 + lseg * 16); rk[1] = *(const u32x4*)(g_ + 1024 + h * 128 + lseg * 16 + 8); \
            _Pragma("unroll") for (int e = 0; e < 4; ++e) rv[e] = *(const u32x4*)(g_ + 2048 + h * 256 + lseg * 32 + e * 8); } while (0)
        RET_LOAD(0);
        __syncthreads();
        const float gC = pw[64];
        for (int n = 0; n < T / 64; ++n) {
            {
                const float z = pw[63 - lrow];
#pragma unroll
                for (int e = 0; e < 2; ++e) {
                    *(LAS u32x4*)(Qs + lrow * PQ + (lseg * 16 + e * 8) * 2) = rq[e];
                    *(LAS u32x4*)(Ks + lrow * PQ + (lseg * 16 + e * 8) * 2) = rk[e];
                    u32x4 kz; kz.x = pkbf(bf_lo(rk[e].x) * z, bf_hi(rk[e].x) * z); kz.y = pkbf(bf_lo(rk[e].y) * z, bf_hi(rk[e].y) * z);
                    kz.z = pkbf(bf_lo(rk[e].z) * z, bf_hi(rk[e].z) * z); kz.w = pkbf(bf_lo(rk[e].w) * z, bf_hi(rk[e].w) * z);
                    *(LAS u32x4*)(Kz + lrow * PQ + (lseg * 16 + e * 8) * 2) = kz;
                }
#pragma unroll
                for (int e = 0; e < 4; ++e) *(LAS u32x4*)(Vs + lrow * PV + (lseg * 32 + e * 8) * 2) = rv[e];
            }
            __syncthreads();
            if (n + 1 < T / 64) RET_LOAD(n + 1);
            for (int u = wid; u < 10; u += 8) {
                const int it = u < 1 ? 0 : (u < 3 ? 1 : (u < 6 ? 2 : 3)), jt = u - (it * (it + 1)) / 2;
                f32x4 acc = (f32x4){0.f, 0.f, 0.f, 0.f};
#pragma unroll
                for (int ks = 0; ks < 4; ++ks) acc = MFMA16(row_frag(Ks, PQ, jt * 16, ks * 32, lane), row_frag(Qs, PQ, it * 16, ks * 32, lane), acc);
                const int i = it * 16 + l15, j0 = jt * 16 + 4 * kg;
                float v[4];
#pragma unroll
                for (int r = 0; r < 4; ++r) { const int dd = i - (j0 + r); v[r] = dd >= 0 ? acc[r] * pw[dd < 0 ? 0 : dd] : 0.f; }
                u32x2 o; o.x = pkbf(v[0], v[1]); o.y = pkbf(v[2], v[3]);
                *(LAS u32x2*)(At + i * PA + j0 * 2) = o;
            }
            __syncthreads();
            f32x4 acc[2][4];
#pragma unroll
            for (int ct = 0; ct < 2; ++ct)
#pragma unroll
                for (int it = 0; it < 4; ++it) acc[ct][it] = (f32x4){0.f, 0.f, 0.f, 0.f};
#pragma unroll
            for (int s4 = 0; s4 < 4; ++s4) {
                const bf16x8 a0 = pack_acc_pair(S[2 * s4][0], S[2 * s4 + 1][0]), a1 = pack_acc_pair(S[2 * s4][1], S[2 * s4 + 1][1]);
#pragma unroll
                for (int it = 0; it < 4; ++it) { const bf16x8 bq = row_frag_perm(Qs, PQ, it * 16, s4 * 32, lane);
                    acc[0][it] = MFMA16(a0, bq, acc[0][it]); acc[1][it] = MFMA16(a1, bq, acc[1][it]); }
            }
#pragma unroll
            for (int it = 0; it < 4; ++it) { const float xi = pw[it * 16 + l15 + 1]; acc[0][it] *= xi; acc[1][it] *= xi; }
            bf16x8 vf[2][2];
#pragma unroll
            for (int ct = 0; ct < 2; ++ct)
#pragma unroll
                for (int ks = 0; ks < 2; ++ks) vf[ct][ks] = tr_frag(Vs, PV, ks * 32, wid * 32 + ct * 16, lane);
#pragma unroll
            for (int it = 0; it < 4; ++it)
#pragma unroll
                for (int ks = 0; ks < 2; ++ks) if (ks == 0 || it >= 2) { const bf16x8 ba = row_frag(At, PA, it * 16, ks * 32, lane);
                    acc[0][it] = MFMA16(vf[0][ks], ba, acc[0][it]); acc[1][it] = MFMA16(vf[1][ks], ba, acc[1][it]); }
#pragma unroll
            for (int dt = 0; dt < 8; ++dt) { S[dt][0] *= gC; S[dt][1] *= gC;
#pragma unroll
                for (int ks = 0; ks < 2; ++ks) { const bf16x8 ak = tr_frag(Kz, PQ, ks * 32, dt * 16, lane);
                    S[dt][0] = MFMA16(ak, vf[0][ks], S[dt][0]); S[dt][1] = MFMA16(ak, vf[1][ks], S[dt][1]); } }
            u32x2 gt[2][4];
#pragma unroll
            for (int it = 0; it < 4; ++it) { const size_t r = (size_t)(b * T + n * 64 + it * 16 + l15);
#pragma unroll
                for (int ct = 0; ct < 2; ++ct) gt[ct][it] = *(const u32x2*)(PR + r * RIN + 4096 + h * 256 + wid * 32 + ct * 16 + 4 * kg); }
#pragma unroll
            for (int it = 0; it < 4; ++it) {
                float sm = 0.f, sq = 0.f;
#pragma unroll
                for (int ct = 0; ct < 2; ++ct)
#pragma unroll
                    for (int r = 0; r < 4; ++r) { const float x = acc[ct][it][r]; sm += x; sq += x * x; }
                sm += __shfl_xor(sm, 16); sm += __shfl_xor(sm, 32); sq += __shfl_xor(sq, 16); sq += __shfl_xor(sq, 32);
                if (kg == 0) *(LAS f32x2*)(part + ((it * 16 + l15) * 8 + wid) * 2) = (f32x2){sm, sq};
            }
            __syncthreads();
#pragma unroll
            for (int it = 0; it < 4; ++it) {
                const int i = it * 16 + l15;
                float sm = 0.f, sq = 0.f;
#pragma unroll
                for (int e = 0; e < 4; ++e) { const f32x4 v = *(LAS const f32x4*)(part + i * 16 + e * 4); sm += v.x; sq += v.y; sm += v.z; sq += v.w; }
                const float mean = sm * (1.0f / 256.0f), rs = rsqrtf(fmaxf(sq * (1.0f / 256.0f) - mean * mean, 0.f) + LN_EPS);
                const size_t r = (size_t)(b * T + n * 64 + i);
#pragma unroll
                for (int ct = 0; ct < 2; ++ct) {
                    const f32x4 o = (acc[ct][it] - mean) * rs; const u32x2 g2 = gt[ct][it];
                    u32x2 w; w.x = pkbf(fsilu(bf_lo(g2.x)) * o[0], fsilu(bf_hi(g2.x)) * o[1]); w.y = pkbf(fsilu(bf_lo(g2.y)) * o[2], fsilu(bf_hi(g2.y)) * o[3]);
                    *(u32x2*)(O2 + r * 2048 + h * 256 + wid * 32 + ct * 16 + 4 * kg) = w;
                }
            }
        }
#undef RET_LOAD
        float* dst = p.out() + O_RP + (size_t)(b * 8 + h) * 128 * 256;
#pragma unroll
        for (int dt = 0; dt < 8; ++dt)
#pragma unroll
            for (int ct = 0; ct < 2; ++ct)
#pragma unroll
                for (int r = 0; r < 4; ++r) dst[(size_t)(dt * 16 + 4 * kg + r) * 256 + wid * 32 + ct * 16 + l15] = S[dt][ct][r];
        return;
    }
    {
        LAS float* qs = (LAS float*)lds; LAS float* ks = qs + 128; LAS float* op = ks + 128;
        const int c4 = (tid & 63) * 4, dw = wid * 16;
        for (int it = bid - n_prompt; it < NS * 8; it += G - n_prompt) {
            const int h = it & 7, sq = it >> 3; const size_t rb = (size_t)(MPR + sq) * RIN;
            const float gamma = 1.0f - exp2f(-5.0f - (float)h);
            const f32x4* s0 = (const f32x4*)(p.in(5) + ((size_t)(sq * 8 + h) * 128 + dw) * 256 + c4);
            f32x4 Sv[16];
#pragma unroll
            for (int dd = 0; dd < 16; ++dd) Sv[dd] = s0[(size_t)dd * 64];
            if (tid < 128) { qs[tid] = bf2f(PR[rb + h * 128 + tid]); ks[tid] = bf2f(PR[rb + 1024 + h * 128 + tid]); }
            const u32x2 vw = *(const u32x2*)(PR + rb + 2048 + h * 256 + c4);
            const f32x4 v = (f32x4){bf_lo(vw.x), bf_hi(vw.x), bf_lo(vw.y), bf_hi(vw.y)};
            __syncthreads();
            f32x4* dst = (f32x4*)(p.out() + O_RS + ((size_t)(sq * 8 + h) * 128 + dw) * 256 + c4);
            f32x4 o = (f32x4){0.f, 0.f, 0.f, 0.f};
#pragma unroll
            for (int dd = 0; dd < 16; ++dd) { const f32x4 sv = Sv[dd] * gamma + v * ks[dw + dd]; dst[(size_t)dd * 64] = sv; o += sv * qs[dw + dd]; }
            *(LAS f32x4*)(op + wid * 256 + c4) = o;
            __syncthreads();
            if (tid < 64) {
                f32x4 ov = (f32x4){0.f, 0.f, 0.f, 0.f};
#pragma unroll
                for (int w8 = 0; w8 < 8; ++w8) ov += *(LAS const f32x4*)(op + w8 * 256 + c4);
                const float mean = wave_sum((ov[0] + ov[1]) + (ov[2] + ov[3])) * (1.0f / 256.0f);
                ov -= mean;
                const float rs = rsqrtf(wave_sum((ov[0] * ov[0] + ov[1] * ov[1]) + (ov[2] * ov[2] + ov[3] * ov[3])) * (1.0f / 256.0f) + LN_EPS);
                const u32x2 gw = *(const u32x2*)(PR + rb + 4096 + h * 256 + c4);
                u32x2 w; w.x = pkbf(fsilu(bf_lo(gw.x)) * ov[0] * rs, fsilu(bf_hi(gw.x)) * ov[1] * rs); w.y = pkbf(fsilu(bf_lo(gw.y)) * ov[2] * rs, fsilu(bf_hi(gw.y)) * ov[3] * rs);
                *(u32x2*)(O2 + (size_t)(MPR + sq) * 2048 + h * 256 + c4) = w;
            }
            __syncthreads();
        }
        weight_prep(p, lds, tid, 2, bid - n_prompt, G - n_prompt);
    }
}

__device__ void final_ln_phase(const Ctx& p, const bf16_t* y, const float* st, const float* lg, const float* lb) {
    const int tid = opaque_tid();
    for (size_t e = (size_t)blockIdx.x * 512 + tid; e < (size_t)MR * (D / 8); e += (size_t)gridDim.x * 512) {
        const int r = (int)(e >> 7), c0 = (int)(e & 127) * 8;
        float mu, rstd; ln_stats(st, r, mu, rstd);
        const u32x4 w = *(const u32x4*)(y + (size_t)r * D + c0);
        f32x4 x0 = (f32x4){bf_lo(w.x), bf_hi(w.x), bf_lo(w.y), bf_hi(w.y)}, x1 = (f32x4){bf_lo(w.z), bf_hi(w.z), bf_lo(w.w), bf_hi(w.w)};
        x0 = (x0 - mu) * rstd * *(const f32x4*)(lg + c0) + *(const f32x4*)(lb + c0);
        x1 = (x1 - mu) * rstd * *(const f32x4*)(lg + c0 + 4) + *(const f32x4*)(lb + c0 + 4);
        float* dst = p.out() + (r < MPR ? O_YP + (size_t)r * D : O_YS + (size_t)(r - MPR) * D) + c0;
        *(f32x4*)dst = x0; *(f32x4*)(dst + 4) = x1;
    }
}

__global__ void __launch_bounds__(512, 2) fwd_megakernel(Params kp) {
    extern __shared__ __attribute__((aligned(16))) unsigned char lds_raw[];
    LAS unsigned char* lds = (LAS unsigned char*)lds_raw;
    cg::grid_group grid = cg::this_grid();
    if (threadIdx.x == 0) {
        LAS unsigned long long* tb = (LAS unsigned long long*)(lds + PTAB_OFF);
#pragma unroll
        for (int i = 0; i < 20; ++i) tb[i] = (unsigned long long)kp.in[i];
        tb[20] = (unsigned long long)kp.out; tb[21] = (unsigned long long)kp.ws;
    }
    __syncthreads();
    Ctx p; p.tab = (const LAS unsigned*)(lds + PTAB_OFF);
    int ph0 = kp.ph_lo; bool need_sync = false;
    if (ph0 == 0) { if (EN(0)) prep_phase(p, lds); ph0 = 1; need_sync = true; }
#if PROBE_MASK
    if (PROBE_MASK & 1) { grid.sync(); prep_phase(p, lds); }
    for (int pi2 = 2 * ph0; pi2 < 2 * kp.ph_hi; ++pi2) {
        const int pi = pi2 >> 1;
        const int ph = pi <= 5 ? pi : (pi == 6 ? 19 : pi - 1);
        if ((pi2 & 1) && !((PROBE_MASK >> ph) & 1)) continue;
#else
    for (int pi = ph0; pi < kp.ph_hi; ++pi) {
        const int ph = pi <= 5 ? pi : (pi == 6 ? 19 : pi - 1);
#endif
        if (need_sync) grid.sync();
        need_sync = true;
        __syncthreads();
        if (ph == 5) { if (EN(5)) gdn_phase_a(p, lds); continue; }
        if (ph == 19) { if (EN(5)) gdn_phase_b(p, lds); continue; }
        if (ph == 10) { if (EN(10)) ret_scan_phase(p, lds); continue; }
        unsigned char* ws = p.ws();
        float* stats = (float*)(ws + WS_STATS);
        const float* ln_g = p.in(18); const float* ln_b = p.in(19);
#define YBUF(s) ((bf16_t*)(ws + (((s) & 1) ? WS_YB : WS_YA)))
#define STATS(s) (stats + (size_t)(s) * MP * 32)
        if (ph == 14) { if (EN(14)) pool_stencil_phase<3>(p, lds, 1, YBUF(5), STATS(5), ln_g + 5 * D, ln_b + 5 * D, (bf16_t*)(ws + WS_O)); continue; }
        if (ph == 18) { if (EN(18)) final_ln_phase(p, YBUF(7), STATS(7), ln_g + 7 * D, ln_b + 7 * D); continue; }
        const int layer = ph <= 3 ? 0 : (ph <= 8 ? 1 : (ph <= 13 ? 2 : 3));
        int kind, lda = D, K = 1024, nN = 4, apn = 0, sin = 0, sout = 0, coff = 0;
        size_t aoff = WS_O, boff = 0;
        if (ph == 1 || ph == 15) { kind = ph == 1 ? E_RES_IN : E_RES_LN; K = 256; apn = 512; boff = WS_WPOOL + (size_t)(ph == 1 ? 0 : 1) * 4 * 65536 * 2; sin = 5; sout = ph == 1 ? 0 : 6; }
        else if (ph == 2 || ph == 7 || ph == 12 || ph == 16) { kind = E_SWIGLU; sin = 2 * layer; aoff = (sin & 1) ? WS_YB : WS_YA; boff = WS_W13 + (size_t)layer * 5632 * 1024 * 2; nN = 22; coff = layer * 5632; }
        else if (ph == 3 || ph == 8 || ph == 13 || ph == 17) { kind = E_RES_LN; sin = 2 * layer; sout = sin + 1; aoff = WS_BIG; lda = DFF; K = DFF; boff = WS_W2 + (size_t)layer * 1024 * 2816 * 2; }
        else if (ph == 4) { kind = E_GDN; sin = 1; aoff = WS_YB; boff = WS_WGI; nN = GINP / 256; coff = 4 * 5632; }
        else if (ph == 6) { kind = E_RES_LN; sin = 1; sout = 2; boff = WS_WGO; }
        else if (ph == 9) { kind = E_RET; sin = 3; aoff = WS_YB; boff = WS_WRI; nN = RIN / 256; coff = 4 * 5632 + GINP; }
        else   { kind = E_RES_LN; sin = 3; sout = 4; lda = 2048; K = 2048; boff = WS_WRO; }
        pg8::Gemm g{(const bf16_t*)(ws + aoff), (const bf16_t*)(ws + boff), lda, K, MP / 256, nN, apn};
        pg8::StaticOrder S; S.init(g.nM, g.nN, gridDim.x, blockIdx.x);
        if (kind == E_RES_IN) { if (EN(1)) { Epi<E_RES_IN> E{}; E.xp = p.in(0); E.xs = p.in(1); E.st_out = STATS(0); E.yout = YBUF(0); pg8::gemm_phase(lds, g, S, E); } }
        else if (kind == E_RES_LN) { if (EN(3)) { Epi<E_RES_LN> E{}; E.st_in = STATS(sin); E.yprev = YBUF(sin); E.lg = ln_g + (size_t)sin * D; E.lb = ln_b + (size_t)sin * D;
            E.st_out = STATS(sout); E.yout = YBUF(sout); pg8::gemm_phase(lds, g, S, E); } }
        else {
            const float* c1 = (const float*)(ws + WS_C1) + coff; const float* c2 = (const float*)(ws + WS_C2) + coff;
            if (kind == E_SWIGLU) { if (EN(2)) { Epi<E_SWIGLU> E{}; E.st_in = STATS(sin); E.c1 = c1; E.c2 = c2; E.ob = (bf16_t*)(ws + WS_BIG); pg8::gemm_phase(lds, g, S, E); } }
            else if (kind == E_GDN) { if (EN(4)) { Epi<E_GDN> E{}; E.st_in = STATS(sin); E.c1 = c1; E.c2 = c2; E.ob = (bf16_t*)(ws + WS_BIG); E.of = (float*)(ws + WS_PROJS); pg8::gemm_phase(lds, g, S, E); } }
            else { if (EN(9)) { Epi<E_RET> E{}; E.st_in = STATS(sin); E.c1 = c1; E.c2 = c2; E.ob = (bf16_t*)(ws + WS_BIG); E.rope = (const float*)(ws + WS_ROPE); pg8::gemm_phase(lds, g, S, E); } }
        }
    }
}

extern "C" void kernel_launch(void* const* d_in, const int* in_sizes, int n_in, void* d_out, int out_size, void* d_ws, size_t ws_size, hipStream_t stream) {
    static int grid = 0;
    if (grid == 0) {
        if (n_in != 20 || (size_t)out_size != O_END || ws_size < WS_END) { fprintf(stderr, "kernel_launch: unexpected shapes: n_in %d out %d (want %zu) ws %zu (want %zu)\n", n_in, out_size, (size_t)O_END, ws_size, (size_t)WS_END); grid = -1; return; }
        int dev = 0, cus = 0, per_cu = 0;
        hipGetDevice(&dev); hipDeviceGetAttribute(&cus, hipDeviceAttributeMultiprocessorCount, dev);
        if (hipFuncSetAttribute((const void*)fwd_megakernel, hipFuncAttributeMaxDynamicSharedMemorySize, LDS_BYTES) != hipSuccess) { fprintf(stderr, "kernel_launch: hipFuncSetAttribute failed\n"); grid = -1; return; }
        if (hipOccupancyMaxActiveBlocksPerMultiprocessor(&per_cu, (const void*)fwd_megakernel, 512, LDS_BYTES) != hipSuccess || per_cu < 1) { fprintf(stderr, "kernel_launch: occupancy query says %d\n", per_cu); per_cu = 1; }
        (void)hipGetLastError();
        grid = cus;
        fprintf(stderr, "kernel_launch: cus %d per_cu %d grid %d\n", cus, per_cu, grid);
    }
    if (grid < 0) return;
    Params p{};
    for (int i = 0; i < 20; ++i) p.in[i] = (const float*)d_in[i];
    p.out = (float*)d_out; p.ws = (unsigned char*)d_ws;
#if N_LAUNCHES == 1
    p.ph_lo = 0; p.ph_hi = NPH;
    void* args[] = {&p};
    hipError_t e = hipLaunchCooperativeKernel((const void*)fwd_megakernel, dim3(grid), dim3(512), args, LDS_BYTES, stream);
    if (e != hipSuccess) fprintf(stderr, "cooperative launch failed: %s (grid %d)\n", hipGetErrorString(e), grid);
#else
    for (int ph = 0; ph < NPH; ++ph) {
        p.ph_lo = ph; p.ph_hi = ph + 1;
        hipLaunchKernelGGL(fwd_megakernel, dim3(grid), dim3(512), LDS_BYTES, stream, p);
    }
#endif
}
```
